# Optimizing an MI355X kernel written in HIP

```python
import math
import jax, jax.numpy as jnp
from jax import lax
import numpy as np

D_MODEL = 2048
BATCH = 4
SEQ = 2048
DEPTH = 4

CHUNK = 64
Q_BLOCK = 128
HEAD_DIM = 128
D_MIX = D_MODEL
D_SB = D_MIX // 2
D_CH = D_MIX - D_SB
N_HEADS_SB = D_SB // HEAD_DIM
N_HEADS_CH = D_CH // HEAD_DIM
LEFT_CHUNKS = 8
BAND = LEFT_CHUNKS + 1
REL_CLIP = 256
N_REL = REL_CLIP + CHUNK
D_IN = 4 * D_SB + 4 * D_CH
NORM_EPS = 1e-6
NEG_BIG = -1e30

kernel_name = "hybrid_stickbreak_chunkband_trunk"


def rms_norm(x, g):
    xf = x.astype(jnp.float32)
    y = xf * lax.rsqrt(jnp.mean(xf * xf, axis=-1, keepdims=True) + NORM_EPS)
    return (y * g.astype(jnp.float32)).astype(x.dtype)


def split_heads(t, n_heads):
    b, s, _ = t.shape
    return t.reshape(b, s, n_heads, HEAD_DIM).transpose(0, 2, 1, 3)


def merge_heads(t):
    b, h, s, d = t.shape
    return t.transpose(0, 2, 1, 3).reshape(b, s, h * d)


def stick_breaking_attention(q, k, v):
    seq = q.shape[2]
    scale = q.shape[-1] ** -0.5
    outs = []
    for blk in range(seq // Q_BLOCK):
        t0 = blk * Q_BLOCK
        t1 = t0 + Q_BLOCK
        qb = q[:, :, t0:t1]
        kb = k[:, :, :t1]
        vb = v[:, :, :t1]
        z = jnp.einsum('bhtd,bhsd->bhts', qb, kb).astype(jnp.float32) * scale
        t_idx = jnp.arange(t0, t1)[:, None]
        s_idx = jnp.arange(t1)[None, :]
        causal = s_idx < t_idx
        log_stay = jnp.where(causal, jax.nn.log_sigmoid(-z), 0.0)
        after = lax.cumsum(log_stay, axis=3, reverse=True) - log_stay
        w = jnp.where(causal, jnp.exp(jax.nn.log_sigmoid(z) + after), 0.0)
        outs.append(jnp.einsum('bhts,bhsd->bhtd', w.astype(v.dtype), vb))
    return jnp.concatenate(outs, axis=2)


def chunk_band_attention(q, k, v, q_gain, k_gain, rel_table):
    b, h, seq, d = q.shape
    nc = seq // CHUNK
    q = rms_norm(q, q_gain)
    k = rms_norm(k, k_gain)
    qc = q.reshape(b, h, nc, CHUNK, d)
    pad = ((0, 0), (0, 0), (LEFT_CHUNKS * CHUNK, 0), (0, 0))
    kc = jnp.pad(k, pad).reshape(b, h, nc + LEFT_CHUNKS, CHUNK, d)
    vc = jnp.pad(v, pad).reshape(b, h, nc + LEFT_CHUNKS, CHUNK, d)
    band_idx = jnp.arange(nc)[:, None] + jnp.arange(BAND)[None, :]
    kband = kc[:, :, band_idx].reshape(b, h, nc, BAND * CHUNK, d)
    vband = vc[:, :, band_idx].reshape(b, h, nc, BAND * CHUNK, d)
    scores = jnp.einsum('bhcid,bhcpd->bhcip', qc, kband).astype(jnp.float32) * (d ** -0.5)
    i_pos = np.arange(CHUNK)[:, None]
    p_pos = np.arange(BAND * CHUNK)[None, :]
    dist = LEFT_CHUNKS * CHUNK + i_pos - p_pos
    rel_idx = np.clip(dist, -(CHUNK - 1), REL_CLIP) + (CHUNK - 1)
    bias = rel_table.astype(jnp.float32)[:, rel_idx]
    scores = scores + bias[None, :, None]
    valid = jnp.repeat(band_idx >= LEFT_CHUNKS, CHUNK, axis=1)
    scores = jnp.where(valid[None, None, :, None, :], scores, NEG_BIG)
    probs = jax.nn.softmax(scores, axis=-1)
    out = jnp.einsum('bhcip,bhcpd->bhcid', probs.astype(v.dtype), vband)
    return out.reshape(b, h, seq, d)


def setup_inputs(seed: int = 0) -> dict:
    key = jax.random.key(seed)
    ks = jax.random.split(key, 8)
    x = jax.random.normal(ks[0], (BATCH, SEQ, D_MODEL), jnp.float32)
    norm_g = 1.0 + 0.02 * jax.random.normal(ks[1], (DEPTH, D_MODEL), jnp.float32)
    w_in = jax.random.normal(ks[2], (DEPTH, D_MODEL, D_IN), jnp.float32) * D_MODEL ** -0.5
    q_norm_g = 1.0 + 0.02 * jax.random.normal(ks[3], (DEPTH, HEAD_DIM), jnp.float32)
    k_norm_g = 1.0 + 0.02 * jax.random.normal(ks[4], (DEPTH, HEAD_DIM), jnp.float32)
    rel_bias = 0.1 * jax.random.normal(ks[5], (DEPTH, N_HEADS_CH, N_REL), jnp.float32)
    w_out = jax.random.normal(ks[6], (DEPTH, D_MIX, D_MODEL), jnp.float32) * D_MIX ** -0.5
    return {"x": x, "norm_g": norm_g, "w_in": w_in, "q_norm_g": q_norm_g,
            "k_norm_g": k_norm_g, "rel_bias": rel_bias, "w_out": w_out}


def reference(x, norm_g, w_in, q_norm_g, k_norm_g, rel_bias, w_out):
    splits = np.cumsum([D_SB, D_SB, D_SB, D_SB, D_CH, D_CH, D_CH])
    for layer in range(DEPTH):
        h = rms_norm(x, norm_g[layer])
        proj = jnp.einsum('bsd,de->bse', h, w_in[layer])
        qa, ka, va, ga, qb, kb, vb, gb = jnp.split(proj, splits, axis=-1)
        ya = stick_breaking_attention(split_heads(qa, N_HEADS_SB),
                                      split_heads(ka, N_HEADS_SB),
                                      split_heads(va, N_HEADS_SB))
        yb = chunk_band_attention(split_heads(qb, N_HEADS_CH),
                                  split_heads(kb, N_HEADS_CH),
                                  split_heads(vb, N_HEADS_CH),
                                  q_norm_g[layer], k_norm_g[layer], rel_bias[layer])
        mixed = jnp.concatenate([merge_heads(ya) * jax.nn.silu(ga),
                                 merge_heads(yb) * jax.nn.silu(gb)], axis=-1)
        x = x + jnp.einsum('bse,ed->bsd', mixed, w_out[layer])
    return x
```

```cpp
#include <hip/hip_runtime.h>
#include <hip/hip_cooperative_groups.h>
#include <cstdio>
#include <cstdint>
namespace cg = cooperative_groups;
namespace pg8 {
#define PG8_LAS __attribute__((address_space(3)))
typedef unsigned short bf16_t;
typedef short bf16x8 __attribute__((ext_vector_type(8)));
typedef float f32x4 __attribute__((ext_vector_type(4)));
typedef unsigned u32x4 __attribute__((ext_vector_type(4)));
constexpr int BM = 256, BK = 64, HALF = 128, HTB = HALF * BK * 2  , STAGE_BYTES = 8 * HTB, NXCD = 8, WGM = 8;

__host__ __device__ __forceinline__ int lds_byte(int r, int c) { const int st = (r >> 4) * 2 + (c >> 5), rr = r & 15, cc = c & 31, ob = rr * 64 + cc * 2; return st * 1024 + (ob ^ (((ob >> 9) & 1) << 5)); }
__host__ __device__ __forceinline__ void stage_rc(int b, int& R, int& C) { const int st = b / 1024, sb = b % 1024, swz = sb ^ (((sb >> 9) & 1) << 5); R = (st >> 1) * 16 + swz / 64; C = (st & 1) * 32 + (swz % 64) / 2; }
__host__ __device__ __forceinline__ int perm32(int rho) { const int n = rho >> 4, i = rho & 15; return 8 * (i >> 2) + 4 * n + (i & 3); }

struct Unit { int pm, pn, ui; };
struct Gemm { const bf16_t* A; const bf16_t* Bt; int M, N, K; };

struct StaticOrder {
    int nM, nN, nwg, G, c, hmap;
    __host__ __device__ void init(int M, int N, int G_, int c_) { nM = M / BM; nN = N / BM; nwg = nM * nN; G = G_; c = c_; hmap = 0; }
    __host__ __device__ bool next(int i, Unit& u) const {
        const long L = (long)i * G + c; if (L >= nwg) return false;
        int wgid = (int)L; { const int q = nwg / NXCD, r = nwg % NXCD, xcd = wgid % NXCD, off = wgid / NXCD; wgid = (xcd < r ? xcd * (q + 1) : r * (q + 1) + (xcd - r) * q) + off; }
        const int nig = WGM * nN, gid = wgid / nig, fm = gid * WGM, gsz = (nM - fm) < WGM ? (nM - fm) : WGM;
        u.pm = fm + ((wgid % nig) % gsz); u.pn = (wgid % nig) / gsz; u.ui = i;
        if (hmap) { const int s = u.pn >> 4, j = u.pn & 15; u.pn = 4 * (j >> 1) + 2 * s + (j & 1); }
        return true;
    }
    __device__ __forceinline__ void a_ready(const Unit&) const {}
    __device__ __forceinline__ void done(const Unit&) const {}
};
struct OneUnit {
    int pm, pn; const unsigned* ready; unsigned need;
    __device__ __forceinline__ bool next(int i, Unit& u) const { if (i) return false; u.pm = pm; u.pn = pn; u.ui = 0; return true; }
    __device__ __forceinline__ void a_ready(const Unit&) const {
        int t_ = threadIdx.x; asm volatile("" : "+v"(t_));
        if (t_ < 64) { unsigned sp = 0;
            while ((unsigned)__builtin_amdgcn_readfirstlane((int)__hip_atomic_load(ready, __ATOMIC_RELAXED, __HIP_MEMORY_SCOPE_AGENT)) < need) { __builtin_amdgcn_s_sleep(2); if (++sp > (1u << 22)) break; }
            __builtin_amdgcn_fence(__ATOMIC_ACQUIRE, "agent");
            asm volatile("s_waitcnt vmcnt(0)" ::: "memory"); }
        asm volatile("" ::: "memory"); __builtin_amdgcn_s_barrier(); asm volatile("" ::: "memory");
    }
    __device__ __forceinline__ void done(const Unit&) const {}
};
struct QuadOrder {
    int pm, s, k; const unsigned* ready; const float* ssq; PG8_LAS float* rsl;
    __device__ __forceinline__ bool next(int i, Unit& u) const { if (i >= 4) return false; const int j = 4 * i + k; u.pm = pm; u.pn = 4 * (j >> 1) + 2 * s + (j & 1); u.ui = i; return true; }
    __device__ __forceinline__ void a_ready(const Unit& u) const {
        if (u.ui != 0) return;
        int t_ = threadIdx.x; asm volatile("" : "+v"(t_));
        if (ready) {
            if (t_ < 64) { unsigned sp = 0;
                while ((unsigned)__builtin_amdgcn_readfirstlane((int)__hip_atomic_load(ready, __ATOMIC_RELAXED, __HIP_MEMORY_SCOPE_AGENT)) < 8u) { __builtin_amdgcn_s_sleep(2); if (++sp > (1u << 22)) break; }
                __builtin_amdgcn_fence(__ATOMIC_ACQUIRE, "agent");
                asm volatile("s_waitcnt vmcnt(0)" ::: "memory"); }
            asm volatile("" ::: "memory"); __builtin_amdgcn_s_barrier(); asm volatile("" ::: "memory");
        }
        const int row = t_ >> 1, hf = t_ & 1;
        const f32x4* pp = (const f32x4*)(ssq + (size_t)(pm * 256 + row) * 32 + hf * 16);
        const f32x4 s4 = (pp[0] + pp[1]) + (pp[2] + pp[3]); float sv = (s4[0] + s4[1]) + (s4[2] + s4[3]);
        sv += __builtin_bit_cast(float, __builtin_amdgcn_ds_bpermute((((t_ & 63) ^ 1) << 2), __builtin_bit_cast(int, sv)));
        if (hf == 0) { const float r = 1.0f / sqrtf(sv * (1.0f / 2048.0f) + 1e-6f); rsl[row] = r; rsl[256 + row] = r; rsl[512 + row] = r; rsl[768 + row] = r; }
    }
    __device__ __forceinline__ void done(const Unit&) const {}
};
__device__ __forceinline__ unsigned cvt_pk_bf16(float lo, float hi) { unsigned r; asm volatile("v_cvt_pk_bf16_f32 %0, %1, %2" : "=v"(r) : "v"(lo), "v"(hi)); return r; }
typedef float f32x2 __attribute__((ext_vector_type(2)));
typedef unsigned u32x4e __attribute__((ext_vector_type(4)));
__device__ __forceinline__ float shfl_xor_l(float v, int lane, int mask) { return __builtin_bit_cast(float, __builtin_amdgcn_ds_bpermute((lane ^ mask) << 2, __builtin_bit_cast(int, v))); }
__device__ __forceinline__ float silu_f(float v) { return v * __builtin_amdgcn_rcpf(1.0f + __builtin_amdgcn_exp2f(-1.4426950408889634f * v)); }
struct EpiProj {
    static constexpr bool PERM = true, AFTER_DRAIN = false;
    bf16_t* O; int mtok; const PG8_LAS float* rs; float* kn;
    __device__ __forceinline__ void operator()(const f32x4 (&acc)[2][2][4][2], const Unit& u, int wr, int wc, int fr, int fq) const {
        const int row0 = u.pm * BM + wr * 64 + fr;
        bf16_t* Oh = O + ((size_t)((u.pn >> 2) * 8 + 2 * (u.pn & 3)) * mtok) * 128 + wc * 32 + 8 * fq;
        const PG8_LAS float* rsu = rs + u.ui * BM + wr * 64 + fr;
        const int grp = u.pn >> 2; const bool gate = (grp & 3) == 3, qk = (grp == 4) || (grp == 5);
        float sq[2][4][2];
#pragma unroll
        for (int ai = 0; ai < 2; ++ai)
#pragma unroll
            for (int m = 0; m < 4; ++m) { bf16_t* rowp = Oh + (size_t)(row0 + ai * HALF + m * 16) * 128; const float rsc = rsu[ai * HALF + m * 16];
#pragma unroll
                for (int bj = 0; bj < 2; ++bj) { f32x4 v0 = acc[ai][bj][m][0] * rsc, v1 = acc[ai][bj][m][1] * rsc;
                    if (gate) { v0 = (f32x4){silu_f(v0[0]), silu_f(v0[1]), silu_f(v0[2]), silu_f(v0[3])}; v1 = (f32x4){silu_f(v1[0]), silu_f(v1[1]), silu_f(v1[2]), silu_f(v1[3])}; }
                    sq[ai][m][bj] = (v0[0] * v0[0] + v0[1] * v0[1]) + (v0[2] * v0[2] + v0[3] * v0[3]) + (v1[0] * v1[0] + v1[1] * v1[1]) + (v1[2] * v1[2] + v1[3] * v1[3]);
                    u32x4e w; w.x = cvt_pk_bf16(v0[0], v0[1]); w.y = cvt_pk_bf16(v0[2], v0[3]); w.z = cvt_pk_bf16(v1[0], v1[1]); w.w = cvt_pk_bf16(v1[2], v1[3]);
                    *(u32x4e*)(rowp + (size_t)bj * mtok * 128) = w; } }
        if (qk) {
            const int hq = (grp - 4) * 8 + 2 * (u.pn & 3);
#pragma unroll
            for (int ai = 0; ai < 2; ++ai)
#pragma unroll
                for (int m = 0; m < 4; ++m)
#pragma unroll
                    for (int bj = 0; bj < 2; ++bj) { float s = sq[ai][m][bj]; s += shfl_xor_l(s, fq * 16 + fr, 16); s += shfl_xor_l(s, fq * 16 + fr, 32);
                        if (fq == 0) kn[((size_t)(hq + bj) * (BM * 32) + (row0 + ai * HALF + m * 16)) * 4 + wc] = s; }
        }
    }
};
struct EpiRes {
    static constexpr bool PERM = true, AFTER_DRAIN = false;
    float* out; bf16_t* xb; float* ssq; int ldc; int last;
    __device__ __forceinline__ void operator()(const f32x4 (&acc)[2][2][4][2], const Unit& u, int wr, int wc, int fr, int fq) const {
        const int row0 = u.pm * BM + wr * 64 + fr; const int col0 = u.pn * BM + wc * 32 + 8 * fq;
        float sq[2][4];
#pragma unroll
        for (int ai = 0; ai < 2; ++ai) {
            u32x4e bv[4][2];
#pragma unroll
            for (int m = 0; m < 4; ++m) { const size_t off = (size_t)(row0 + ai * HALF + m * 16) * ldc + col0;
#pragma unroll
                for (int bj = 0; bj < 2; ++bj) bv[m][bj] = *(const u32x4e*)(xb + off + bj * HALF); }
#pragma unroll
            for (int m = 0; m < 4; ++m) { const size_t off = (size_t)(row0 + ai * HALF + m * 16) * ldc + col0; float s = 0.f;
#pragma unroll
                for (int bj = 0; bj < 2; ++bj) {
                    const u32x4e b = bv[m][bj];
                    const f32x4 x0 = (f32x4){__builtin_bit_cast(float, b.x << 16), __builtin_bit_cast(float, b.x & 0xffff0000u), __builtin_bit_cast(float, b.y << 16), __builtin_bit_cast(float, b.y & 0xffff0000u)} + acc[ai][bj][m][0];
                    const f32x4 x1 = (f32x4){__builtin_bit_cast(float, b.z << 16), __builtin_bit_cast(float, b.z & 0xffff0000u), __builtin_bit_cast(float, b.w << 16), __builtin_bit_cast(float, b.w & 0xffff0000u)} + acc[ai][bj][m][1];
                    if (last) { *(f32x4*)(out + off + bj * HALF) = x0; *(f32x4*)(out + off + bj * HALF + 4) = x1; }
                    else {
                        u32x4e w; w.x = cvt_pk_bf16(x0[0], x0[1]); w.y = cvt_pk_bf16(x0[2], x0[3]); w.z = cvt_pk_bf16(x1[0], x1[1]); w.w = cvt_pk_bf16(x1[2], x1[3]);
                        asm volatile("global_store_dwordx4 %0, %1, off sc1\n\ts_nop 1" :: "v"(xb + off + bj * HALF), "v"(w) : "memory");
                        s += (x0[0] * x0[0] + x0[1] * x0[1]) + (x0[2] * x0[2] + x0[3] * x0[3]) + (x1[0] * x1[0] + x1[1] * x1[1]) + (x1[2] * x1[2] + x1[3] * x1[3]); } }
                sq[ai][m] = s; }
            asm volatile("" ::: "memory");
        }
        if (last) return;
#pragma unroll
        for (int ai = 0; ai < 2; ++ai)
#pragma unroll
            for (int m = 0; m < 4; ++m) {
                const float s1 = sq[ai][m] + shfl_xor_l(sq[ai][m], fq * 16 + fr, 16);
                const float s2 = s1 + shfl_xor_l(s1, fq * 16 + fr, 32);
                if (fq == 0) __hip_atomic_store(ssq + (size_t)(row0 + ai * HALF + m * 16) * 32 + u.pn * 4 + wc, s2, __ATOMIC_RELAXED, __HIP_MEMORY_SCOPE_AGENT); }
    }
};
template <class Epi, class Sched, bool ALIGN_EPI = false, bool SP2 = false>
__device__ __forceinline__ void gemm_phase(PG8_LAS unsigned char* lds, const Gemm g, const Sched& S, const Epi& E) {
    int tid_ = threadIdx.x; asm volatile("" : "+v"(tid_));
    const int tid = tid_, wid = __builtin_amdgcn_readfirstlane(tid >> 6), lane = tid & 63, wr = wid >> 2, wc = wid & 3, fr = lane & 15, fq = lane >> 4;
    const int K = g.K, nt = K / BK;
    unsigned voffA[2], voffB[2];
#pragma unroll
    for (int i = 0; i < 2; ++i) { int R, C; stage_rc(tid * 16 + i * 8192, R, C); const int Rb = Epi::PERM ? ((R & ~31) + perm32(R & 31)) : R;
        voffA[i] = (unsigned)(R * K + C) * 2u; voffB[i] = (unsigned)(Rb * K + C) * 2u; }
    const size_t kstep = (size_t)(BK * 2);
    const size_t hstep = (size_t)HALF * K * 2;
    const size_t tstep = 2 * hstep;
    const unsigned ldsw = (unsigned)wid * 1024u;
    const int aoff = lds_byte(wr * 64 + fr, fq * 8), boff = lds_byte(wc * 32 + fr, fq * 8);
#define PG8_SA(b, h) (((b) * 2 + (h)) * HTB)
#define PG8_SB(b, h) ((4 + (b) * 2 + (h)) * HTB)
#define PG8_STAGE(bufoff, gbase, voff) do { _Pragma("unroll") for (int _i = 0; _i < 2; ++_i) \
        __builtin_amdgcn_global_load_lds((const unsigned*)((const char*)(gbase) + (voff)[_i]), (PG8_LAS unsigned*)(lds + (bufoff) + ldsw + _i * 8192), 16, 0, 0); } while (0)
#define PG8_LDA(dst, b, h) do { _Pragma("unroll") for (int m = 0; m < 4; ++m) _Pragma("unroll") for (int k = 0; k < 2; ++k) dst[m][k] = *(const PG8_LAS bf16x8*)(lds + PG8_SA(b, h) + aoff + m * 2048 + k * 1024); } while (0)
#define PG8_LDB(dst, b, h) do { _Pragma("unroll") for (int n = 0; n < 2; ++n) _Pragma("unroll") for (int k = 0; k < 2; ++k) dst[n][k] = *(const PG8_LAS bf16x8*)(lds + PG8_SB(b, h) + boff + n * 2048 + k * 1024); } while (0)
#define PG8_MMA(ai, bj, At, Bt) do { __builtin_amdgcn_s_setprio(1); _Pragma("unroll") for (int m = 0; m < 4; ++m) _Pragma("unroll") for (int n = 0; n < 2; ++n) _Pragma("unroll") for (int k = 0; k < 2; ++k) \
        acc[ai][bj][m][n] = __builtin_amdgcn_mfma_f32_16x16x32_bf16(Bt[n][k], At[m][k], acc[ai][bj][m][n], 0, 0, 0); __builtin_amdgcn_s_setprio(0); } while (0)
#define PG8_WAIT_V(n) asm volatile("s_waitcnt vmcnt(" #n ")" ::: "memory")
#define PG8_WAIT_L(n) asm volatile("s_waitcnt lgkmcnt(" #n ")" ::: "memory")
#define PG8_BAR __builtin_amdgcn_s_barrier()
#define PG8_SCHED __builtin_amdgcn_sched_barrier(0)
    Unit cur, nxt; int ui = 0;
    if (!S.next(0, cur)) return;
    f32x4 acc[2][2][4][2];
#pragma unroll
    for (int a = 0; a < 2; ++a)
#pragma unroll
        for (int b = 0; b < 2; ++b)
#pragma unroll
            for (int m = 0; m < 4; ++m)
#pragma unroll
                for (int n = 0; n < 2; ++n) acc[a][b][m][n] = (f32x4){0.f, 0.f, 0.f, 0.f};
    bf16x8 At[4][2], B0[2][2], B1[2][2];
    const char* cA = (const char*)g.A + (size_t)cur.pm * tstep; const char* cB = (const char*)g.Bt + (size_t)cur.pn * tstep;
    if constexpr (!SP2) S.a_ready(cur);
    if constexpr (SP2) {
        PG8_STAGE(PG8_SB(0, 0), cB, voffB); PG8_STAGE(PG8_SB(0, 1), cB + hstep, voffB);
        S.a_ready(cur);
        PG8_STAGE(PG8_SA(0, 0), cA, voffA); PG8_STAGE(PG8_SA(0, 1), cA + hstep, voffA);
        if (wr == 1) PG8_BAR;
        PG8_WAIT_V(2); PG8_BAR;
        PG8_STAGE(PG8_SB(1, 0), cB + kstep, voffB); PG8_STAGE(PG8_SA(1, 0), cA + kstep, voffA); PG8_STAGE(PG8_SB(1, 1), cB + hstep + kstep, voffB);
        PG8_WAIT_V(6); PG8_BAR;
    } else {
        PG8_STAGE(PG8_SB(0, 0), cB, voffB); PG8_STAGE(PG8_SA(0, 0), cA, voffA); PG8_STAGE(PG8_SB(0, 1), cB + hstep, voffB); PG8_STAGE(PG8_SA(0, 1), cA + hstep, voffA);
        if (wr == 1) PG8_BAR;
        PG8_WAIT_V(4); PG8_BAR;
        PG8_STAGE(PG8_SB(1, 0), cB + kstep, voffB); PG8_STAGE(PG8_SA(1, 0), cA + kstep, voffA); PG8_STAGE(PG8_SB(1, 1), cB + hstep + kstep, voffB);
        PG8_WAIT_V(6); PG8_BAR;
    }
    for (;;) {
        const bool has_next = S.next(ui + 1, nxt);
        const char* nA = has_next ? (const char*)g.A + (size_t)nxt.pm * tstep : cA; const char* nB = has_next ? (const char*)g.Bt + (size_t)nxt.pn * tstep : cB;
        for (int t = 0; t < nt; t += 2) {
            const bool last = (t == nt - 2);
            const char* a1 = cA + (size_t)(t + 1) * kstep;
            const char* a2 = last ? nA : cA + (size_t)(t + 2) * kstep; const char* b2 = last ? nB : cB + (size_t)(t + 2) * kstep;
            const char* a3 = a2 + kstep; const char* b3 = b2 + kstep;
            if (last && has_next) S.a_ready(nxt);
            if constexpr (SP2) {
            PG8_LDB(B0, 0, 0); PG8_LDB(B1, 0, 1); PG8_SCHED; PG8_LDA(At, 0, 0); PG8_STAGE(PG8_SA(1, 1), a1 + hstep, voffA);
            PG8_WAIT_V(8); PG8_WAIT_L(0); PG8_BAR; PG8_MMA(0, 0, At, B0); PG8_MMA(0, 1, At, B1); PG8_BAR; PG8_SCHED;
            PG8_LDA(At, 0, 1); PG8_STAGE(PG8_SB(0, 0), b2, voffB); PG8_STAGE(PG8_SB(0, 1), b2 + hstep, voffB); PG8_STAGE(PG8_SA(0, 0), a2, voffA);
            PG8_WAIT_V(8); PG8_WAIT_L(0); PG8_BAR; PG8_MMA(1, 0, At, B0); PG8_MMA(1, 1, At, B1); PG8_BAR; PG8_SCHED;
            PG8_LDB(B0, 1, 0); PG8_LDB(B1, 1, 1); PG8_SCHED; PG8_LDA(At, 1, 0); PG8_STAGE(PG8_SA(0, 1), a2 + hstep, voffA);
            PG8_WAIT_V(8); PG8_WAIT_L(0); PG8_BAR; PG8_MMA(0, 0, At, B0); PG8_MMA(0, 1, At, B1); PG8_BAR; PG8_SCHED;
            PG8_LDA(At, 1, 1); PG8_STAGE(PG8_SB(1, 0), b3, voffB); PG8_STAGE(PG8_SB(1, 1), b3 + hstep, voffB); PG8_STAGE(PG8_SA(1, 0), a3, voffA);
            PG8_WAIT_V(8); PG8_WAIT_L(0); PG8_BAR; PG8_MMA(1, 0, At, B0); PG8_MMA(1, 1, At, B1); PG8_BAR; PG8_SCHED;
            } else {
            PG8_LDB(B0, 0, 0); PG8_SCHED; PG8_LDA(At, 0, 0); PG8_STAGE(PG8_SA(1, 1), a1 + hstep, voffA);
            PG8_WAIT_L(8); PG8_BAR; PG8_WAIT_L(0); PG8_MMA(0, 0, At, B0); PG8_BAR; PG8_SCHED;
            PG8_LDB(B1, 0, 1); PG8_STAGE(PG8_SB(0, 0), b2, voffB);
            PG8_BAR; PG8_WAIT_L(0); PG8_MMA(0, 1, At, B1); PG8_BAR;
            PG8_LDA(At, 0, 1); PG8_STAGE(PG8_SA(0, 0), a2, voffA);
            PG8_BAR; PG8_WAIT_L(0); PG8_MMA(1, 0, At, B0); PG8_BAR; PG8_SCHED;
            PG8_STAGE(PG8_SB(0, 1), b2 + hstep, voffB);
            PG8_WAIT_V(6); PG8_BAR; PG8_MMA(1, 1, At, B1); PG8_BAR;
            PG8_LDB(B0, 1, 0); PG8_SCHED; PG8_LDA(At, 1, 0); PG8_STAGE(PG8_SA(0, 1), a2 + hstep, voffA);
            PG8_WAIT_L(8); PG8_BAR; PG8_WAIT_L(0); PG8_MMA(0, 0, At, B0); PG8_BAR; PG8_SCHED;
            PG8_LDB(B1, 1, 1); PG8_STAGE(PG8_SB(1, 0), b3, voffB);
            PG8_BAR; PG8_WAIT_L(0); PG8_MMA(0, 1, At, B1); PG8_BAR;
            PG8_LDA(At, 1, 1); PG8_STAGE(PG8_SA(1, 0), a3, voffA);
            PG8_BAR; PG8_WAIT_L(0); PG8_MMA(1, 0, At, B0); PG8_BAR; PG8_SCHED;
            PG8_STAGE(PG8_SB(1, 1), b3 + hstep, voffB);
            PG8_WAIT_V(6); PG8_BAR; PG8_MMA(1, 1, At, B1); PG8_BAR;
            }
        }
        if constexpr (ALIGN_EPI) { if (wr == 0) PG8_BAR; }
        if constexpr (!Epi::AFTER_DRAIN) { E(acc, cur, wr, wc, fr, fq); S.done(cur); }
        if (!has_next) break;
#pragma unroll
        for (int a = 0; a < 2; ++a)
#pragma unroll
            for (int b = 0; b < 2; ++b)
#pragma unroll
                for (int m = 0; m < 4; ++m)
#pragma unroll
                    for (int n = 0; n < 2; ++n) acc[a][b][m][n] = (f32x4){0.f, 0.f, 0.f, 0.f};
        cur = nxt; cA = nA; cB = nB; ++ui;
        if constexpr (ALIGN_EPI) { if (wr == 1) PG8_BAR; }
    }
    PG8_WAIT_V(0);
    if constexpr (!ALIGN_EPI) { if (wr == 0) PG8_BAR; }
    PG8_BAR;
    if constexpr (Epi::AFTER_DRAIN) { E.fused(acc, cur, wr, wc, fr, fq, lds, wid, lane); S.done(cur); }
#undef PG8_SA
#undef PG8_SB
#undef PG8_STAGE
#undef PG8_LDA
#undef PG8_LDB
#undef PG8_MMA
#undef PG8_WAIT_V
#undef PG8_WAIT_L
#undef PG8_BAR
#undef PG8_SCHED
}
}
constexpr int BATCH = 4, SEQ = 2048, DM = 2048, DEPTH = 4, HD = 128, NH = 8, DIN = 8192, MTOK = BATCH * SEQ, NREL = 320;
constexpr float EPS = 1e-6f, LOG2E = 1.4426950408889634f, QSCALE = 0.08838834764831845f;
constexpr size_t MiB = 1u << 20;
constexpr size_t WS_CTL = 0, WS_WIN = 1 * MiB, WS_WOUT = 129 * MiB, WS_XN = 161 * MiB, WS_PROJ = 193 * MiB, WS_MIX = 321 * MiB, WS_SSQ = 353 * MiB, WS_KN = 354 * MiB, WS_PROJ1 = 356 * MiB, WS_KN1 = 484 * MiB, WS_END = 486 * MiB;
constexpr int LDS_BYTES = 139264, RS_OFF = 131072, MISC_OFF = 135168 + 1024;
constexpr int CW_BAR = 6144, CW_CNT = 2048, CW_CNTA = 4096, CTL_ZERO_BYTES = 40960;
constexpr int LDS_BYTES_ = 135168;

#define LAS __attribute__((address_space(3)))
typedef unsigned short bf16;
typedef short bf16x8 __attribute__((ext_vector_type(8)));
typedef short v4i16_t __attribute__((ext_vector_type(4)));
typedef float f32x4 __attribute__((ext_vector_type(4)));
typedef float f32x16 __attribute__((ext_vector_type(16)));
typedef unsigned u32x4 __attribute__((ext_vector_type(4)));
typedef unsigned u32x2 __attribute__((ext_vector_type(2)));
typedef float f32x2_t __attribute__((ext_vector_type(2)));
typedef __bf16 bf16x2_t __attribute__((ext_vector_type(2)));
__device__ __forceinline__ unsigned cvtpk(float lo, float hi) { f32x2_t v = {lo, hi}; bf16x2_t b = __builtin_convertvector(v, bf16x2_t); return __builtin_bit_cast(unsigned, b); }
__device__ __forceinline__ float bflo(unsigned u) { return __uint_as_float(u << 16); }
__device__ __forceinline__ float bfhi(unsigned u) { return __uint_as_float(u & 0xffff0000u); }
__device__ __forceinline__ float partner(float x, int hi) { auto rr = __builtin_amdgcn_permlane32_swap(__float_as_uint(x), __float_as_uint(x), false, false); return __uint_as_float(hi ? rr[0] : rr[1]); }
__device__ __forceinline__ float wave_sum(float v) {
#pragma unroll
    for (int o = 1; o < 64; o <<= 1) v += __shfl_xor(v, o);
    return v;
}

#define XB_TMO      128
#define XB_XCNT(j)  (256  + 64 * (j))
#define XB_XSUB(j)  (1280 + 64 * (j))
#define XB_XGEN(j)  (2304 + 64 * (j))
#define XB_TOP      3328
#define XB_TOPGEN   3392
#define XCD_BAR_WORDS 3456
#define XB_SPIN_CAP (1u << 18)

__device__ __forceinline__ unsigned xb_ld(unsigned* p)              { return __hip_atomic_load(p, __ATOMIC_RELAXED, __HIP_MEMORY_SCOPE_AGENT); }
__device__ __forceinline__ unsigned xb_add(unsigned* p, unsigned v) { return __hip_atomic_fetch_add(p, v, __ATOMIC_RELAXED, __HIP_MEMORY_SCOPE_AGENT); }
__device__ __forceinline__ unsigned xb_xcc_id() { return (unsigned)__builtin_amdgcn_s_getreg((3 << 11) | 20) & 0xFu; }
#define XB_SPIN(cond, bar) do { unsigned _sp = 0; while (cond) { __builtin_amdgcn_s_sleep(1); \
    if ((++_sp & 255u) == 0u) { if (xb_ld(&(bar)[XB_TMO])) break; if (_sp > XB_SPIN_CAP) { atomicAdd(&(bar)[XB_TMO], 1u); break; } } } } while (0)

struct XcdBarrier {
    unsigned* bar; unsigned x;
    volatile LAS unsigned* st;
};

__device__ __forceinline__ XcdBarrier xcd_barrier_post(unsigned* bar, volatile LAS unsigned* st) {
    XcdBarrier b; b.bar = bar; b.x = xb_xcc_id(); b.st = st;
    if (threadIdx.x == 0) (void)xb_add(&bar[XB_XCNT(b.x)], 1u);
    return b;
}
__device__ __forceinline__ void xcd_barrier_complete(unsigned* bar, unsigned x, unsigned& nloc, unsigned& nx) {
    const unsigned G = gridDim.x * gridDim.y * gridDim.z;
    unsigned sum, cnt, mine, sp = 0u;
    for (;;) {
        sum = 0u; cnt = 0u; mine = 0u;
#pragma unroll
        for (unsigned j = 0; j < 16; ++j) { const unsigned c = xb_ld(&bar[XB_XCNT(j)]); sum += c; cnt += (c > 0u) ? 1u : 0u; mine = (j == x) ? c : mine; }
        if (sum == G) break;
        __builtin_amdgcn_s_sleep(1);
        if ((++sp & 255u) == 0u) { if (xb_ld(&bar[XB_TMO])) break; if (sp > XB_SPIN_CAP) { atomicAdd(&bar[XB_TMO], 1u); break; } }
    }
    nloc = mine > 0u ? mine : 1u; nx = cnt > 0u ? cnt : 1u;
}

__device__ __forceinline__ void xcd_barrier(const XcdBarrier& b) {
    int t0_ = threadIdx.x; asm volatile("" : "+v"(t0_));
    asm volatile("s_waitcnt vmcnt(0)" ::: "memory");
    __syncthreads();
    if (t0_ == 0) {
        unsigned* bar = b.bar;
        __builtin_amdgcn_s_waitcnt(0);
        unsigned nloc = b.st[0], nx = b.st[1];
        if (nloc == 0u) { xcd_barrier_complete(bar, b.x, nloc, nx); b.st[0] = nloc; b.st[1] = nx; }
        const unsigned old = xb_add(&bar[XB_XSUB(b.x)], 1u);
        const unsigned gen = old / nloc;
        if (old + 1u == (gen + 1u) * nloc) {
            __builtin_amdgcn_fence(__ATOMIC_RELEASE, "agent");
            asm volatile("s_waitcnt vmcnt(0)" ::: "memory");
            const unsigned og = xb_add(&bar[XB_TOP], 1u);
            const unsigned tg = og / nx;
            if (og + 1u == (tg + 1u) * nx) xb_add(&bar[XB_TOPGEN], 1u);
            else XB_SPIN(xb_ld(&bar[XB_TOPGEN]) == tg, bar);
            __builtin_amdgcn_fence(__ATOMIC_ACQUIRE, "agent");
            xb_add(&bar[XB_XGEN(b.x)], 1u);
            asm volatile("s_waitcnt vmcnt(0)" ::: "memory");
        } else {
            XB_SPIN(xb_ld(&bar[XB_XGEN(b.x)]) == gen, bar);
            __builtin_amdgcn_fence(__ATOMIC_ACQUIRE, "agent");
            asm volatile("s_waitcnt vmcnt(0)" ::: "memory");
        }
    }
    __syncthreads();
}

__device__ __forceinline__ void grid_barrier(const XcdBarrier& b) {
    XcdBarrier c = b; unsigned long long p = (unsigned long long)c.bar; unsigned x = c.x;
    asm volatile("" : "+s"(p), "+s"(x));
    c.bar = (unsigned*)p; c.x = x;
    xcd_barrier(c);
}

__device__ __forceinline__ void transpose_item(const float* __restrict__ W, const float* __restrict__ gain, int K, int N, bf16* __restrict__ WT, LAS float* scr, int item, int lane) {
    const int nblk = N / 32, jb = item >> 3, nbh = jb % (nblk / 4), kbh = jb / (nblk / 4), nb = 4 * nbh + (item & 3), kb = 2 * kbh + ((item >> 2) & 1), k0 = 64 * kb, n0 = 32 * nb;
#pragma unroll 8
    for (int i = 0; i < 32; ++i) { const int kk = 2 * i + (lane >> 5); scr[kk * 33 + (lane & 31)] = W[(size_t)(k0 + kk) * N + n0 + (lane & 31)]; }
    asm volatile("s_waitcnt lgkmcnt(0)" ::: "memory");
    const int c = lane & 7;
    f32x4 ga = {1.f, 1.f, 1.f, 1.f}, gb = {1.f, 1.f, 1.f, 1.f};
    if (gain) { ga = *(const f32x4*)(gain + k0 + 8 * c); gb = *(const f32x4*)(gain + k0 + 8 * c + 4); }
#pragma unroll
    for (int j = 0; j < 4; ++j) { const int n = (lane >> 3) + 8 * j; const LAS float* s = scr + (8 * c) * 33 + n;
        u32x4 o; o.x = cvtpk(s[0 * 33] * ga.x, s[1 * 33] * ga.y); o.y = cvtpk(s[2 * 33] * ga.z, s[3 * 33] * ga.w); o.z = cvtpk(s[4 * 33] * gb.x, s[5 * 33] * gb.y); o.w = cvtpk(s[6 * 33] * gb.z, s[7 * 33] * gb.w);
        *(u32x4*)(WT + (size_t)(n0 + n) * K + k0 + 8 * c) = o; }
    asm volatile("s_waitcnt lgkmcnt(0)" ::: "memory");
}
__device__ __forceinline__ void cast_rows(const float* __restrict__ x, bf16* __restrict__ out, float* __restrict__ ssq, int gw, int ngw, int lane) {
    for (int m = gw; m < MTOK; m += ngw) {
        const f32x4* xr = (const f32x4*)(x + (size_t)m * DM) + lane;
        u32x2* o = (u32x2*)(out + (size_t)m * DM) + lane;
        float s = 0.f;
#pragma unroll
        for (int j = 0; j < 8; ++j) { const f32x4 v = xr[64 * j]; s += (v.x * v.x + v.y * v.y) + (v.z * v.z + v.w * v.w); u32x2 w; w.x = cvtpk(v.x, v.y); w.y = cvtpk(v.z, v.w); o[64 * j] = w; }
        s = wave_sum(s);
        if (lane < 32) ssq[(size_t)m * 32 + lane] = lane == 0 ? s : 0.f;
    }
}

namespace att {
constexpr int TILEB = 16384, BUFB = 2 * TILEB, NBUF = 3;
constexpr int OFF_RK = NBUF * BUFB, OFF_TAB = OFF_RK + 3072, OFF_GQK = OFF_TAB + 1536, OFF_FLAG = OFF_GQK + 512, OFF_QIDX = OFF_FLAG + 64, LDS_NEED = OFF_QIDX + 16;
constexpr int NPT = 383;
static_assert(LDS_NEED <= 131072, "attention LDS");
__device__ __forceinline__ int swz(int row) { return ((row & 3) << 2) | ((row >> 2) & 3); }

template <int MODE>
__device__ __forceinline__ void unit(LAS unsigned char* lds, const bf16* __restrict__ proj, bf16* __restrict__ mix, int b, int h, int blk,
                                     const float* __restrict__ qg, const float* __restrict__ kg, const float* __restrict__ rel, const float* __restrict__ kn, unsigned* cnt) {
    int tid_ = threadIdx.x; asm volatile("" : "+v"(tid_));
    const int tid = tid_, lane = tid & 63, wid = __builtin_amdgcn_readfirstlane(tid >> 6), r32 = lane & 31, hi = lane >> 5;
    constexpr int G0 = MODE ? 4 : 0;
    const bf16* pq = proj + (size_t)((G0 + 0) * 8 + h) * MTOK * HD; const bf16* pk = proj + (size_t)((G0 + 1) * 8 + h) * MTOK * HD;
    const bf16* pv = proj + (size_t)((G0 + 2) * 8 + h) * MTOK * HD; const bf16* pg = proj + (size_t)((G0 + 3) * 8 + h) * MTOK * HD; const int mcol = MODE * 1024 + h * HD;
    const int q0 = blk * 256, tw = q0 + 32 * wid;
    const size_t rowb = (size_t)b * SEQ;
    LAS float* RK = (LAS float*)(lds + OFF_RK); LAS float* TAB = (LAS float*)(lds + OFF_TAB); LAS float* GQK = (LAS float*)(lds + OFF_GQK);
    int kt_first, kt_step, ntile;
    if (MODE == 0) { kt_first = blk * 4 + 3; kt_step = -1; ntile = blk * 4 + 4; }
    else { const int lo = blk * 4 - 8 < 0 ? 0 : blk * 4 - 8; kt_first = lo; kt_step = 1; ntile = blk * 4 + 3 - lo + 1; }
    unsigned gofs[2];
#pragma unroll
    for (int j = 0; j < 2; ++j) { const int r = 4 * (2 * wid + j) + (lane >> 4); gofs[j] = (unsigned)(r * HD + (((lane & 15) ^ swz(r)) << 3)); }
    const bf16* kbase = pk + rowb * HD; const bf16* vbase = pv + rowb * HD;
#define ATT_DMA(kt, bi) do { const size_t to_ = (size_t)(64 * (kt)) * HD; LAS unsigned char* d_ = lds + (bi) * BUFB + wid * 2048; _Pragma("unroll") for (int j_ = 0; j_ < 2; ++j_) { \
        __builtin_amdgcn_global_load_lds((const unsigned*)(kbase + to_ + gofs[j_]), (LAS unsigned*)(d_ + j_ * 1024), 16, 0, 0); \
        __builtin_amdgcn_global_load_lds((const unsigned*)(vbase + to_ + gofs[j_]), (LAS unsigned*)(d_ + TILEB + j_ * 1024), 16, 0, 0); } } while (0)
    ATT_DMA(kt_first, 0);
    if (ntile > 1) ATT_DMA(kt_first + kt_step, 1);
    bf16x8 qf[8];
    { const bf16* qrow = pq + (rowb + tw + r32) * HD + 8 * hi;
#pragma unroll
      for (int d0 = 0; d0 < 8; ++d0) qf[d0] = *(const bf16x8*)(qrow + 16 * d0); }
    float rq = 1.0f;
    if (MODE == 1) {
        if (tid < NPT) TAB[tid] = rel[h * NREL + (NREL - 1) - (tid > 63 ? tid - 63 : 0)] * LOG2E;
        if (tid < HD) GQK[tid] = qg[tid] * kg[tid] * (QSCALE * LOG2E);
        const f32x4 qp = *(const f32x4*)(kn + ((size_t)h * MTOK + rowb + tw + r32) * 4);
        rq = 1.0f / sqrtf(((qp.x + qp.y) + (qp.z + qp.w)) * (1.0f / HD) + EPS);
        const int nkeys = 64 * ntile; const float* knk = kn + ((size_t)(8 + h) * MTOK + rowb + 64 * kt_first) * 4;
#pragma unroll
        for (int i = 0; i < 2; ++i) { const int key = tid + 512 * i; if (key < nkeys) { const f32x4 kp = *(const f32x4*)(knk + (size_t)key * 4); RK[key] = 1.0f / sqrtf(((kp.x + kp.y) + (kp.z + kp.w)) * (1.0f / HD) + EPS); } }
    }
    asm volatile("s_waitcnt vmcnt(0) lgkmcnt(0)" ::: "memory");
    __builtin_amdgcn_s_barrier();
    asm volatile("" ::: "memory");
    if (MODE == 1) {
#pragma unroll
        for (int d0 = 0; d0 < 8; ++d0) { const u32x4 u = __builtin_bit_cast(u32x4, qf[d0]); const f32x4 g0 = *(const LAS f32x4*)(GQK + 16 * d0 + 8 * hi), g1 = *(const LAS f32x4*)(GQK + 16 * d0 + 8 * hi + 4);
            u32x4 o; o.x = cvtpk(bflo(u.x) * rq * g0.x, bfhi(u.x) * rq * g0.y); o.y = cvtpk(bflo(u.y) * rq * g0.z, bfhi(u.y) * rq * g0.w);
            o.z = cvtpk(bflo(u.z) * rq * g1.x, bfhi(u.z) * rq * g1.y); o.w = cvtpk(bflo(u.w) * rq * g1.z, bfhi(u.w) * rq * g1.w);
            qf[d0] = __builtin_bit_cast(bf16x8, o); }
    }
    f32x16 O[4];
#pragma unroll
    for (int i = 0; i < 4; ++i) O[i] = f32x16{};
    float carry = 1.0f, mrun = -1e30f, lrun = 0.f;
    bool wdone = false;
    LAS unsigned* FLG = (LAS unsigned*)(lds + OFF_FLAG);
    const int g4 = (r32 >> 2) & 3;
    const int pi = (r32 & 16) + (g4 == 1 ? 8 : g4 == 2 ? 4 : g4 * 4) + (r32 & 3);
    int kx[8], vx[4][2];
#pragma unroll
    for (int e = 0; e < 8; ++e) kx[e] = 256 * pi + 16 * ((2 * e + hi) ^ swz(pi));
    { const int q = (lane & 15) >> 2, p = lane & 3, bk = (lane >> 4) & 1;
#pragma unroll
      for (int db = 0; db < 4; ++db)
#pragma unroll
          for (int t = 0; t < 2; ++t) vx[db][t] = TILEB + 256 * (8 * hi + 4 * t + q) + 16 * (((db ^ q) << 2) | ((2 * bk + (p >> 1)) ^ (2 * hi + t))) + 8 * (p & 1); }
    const int cw = blk * 4 + (wid >> 1);
    int cur = 0;
    for (int it = 0; it < ntile; ++it) {
        const int kt = kt_first + kt_step * it;
        const int nx1 = cur == 2 ? 0 : cur + 1, nx2 = nx1 == 2 ? 0 : nx1 + 1;
        if (it + 2 < ntile) ATT_DMA(kt + 2 * kt_step, nx2);
        const LAS unsigned char* Kb = lds + cur * BUFB;
#define ATT_SBAR() __builtin_amdgcn_sched_barrier(0)
#define ATT_KLOAD(KF, b2) do { const LAS unsigned char* Kh_ = Kb + (b2) * 8192; _Pragma("unroll") for (int d0 = 0; d0 < 8; ++d0) KF[d0] = *(const LAS bf16x8*)(Kh_ + kx[d0]); } while (0)
#define ATT_QK2(PA, KA, PB, KB) do { PA = f32x16{}; PB = f32x16{}; _Pragma("unroll") for (int d0 = 0; d0 < 8; ++d0) { \
            PA = __builtin_amdgcn_mfma_f32_32x32x16_bf16(KA[d0], qf[d0], PA, 0, 0, 0); PB = __builtin_amdgcn_mfma_f32_32x32x16_bf16(KB[d0], qf[d0], PB, 0, 0, 0); } } while (0)
#define ATT_VLOAD(VF, b2) do { const LAS unsigned char* Kh_ = Kb + (b2) * 8192; _Pragma("unroll") for (int j = 0; j < 2; ++j) _Pragma("unroll") for (int db = 0; db < 4; ++db) { \
                const v4i16_t lo_ = __builtin_amdgcn_ds_read_tr16_b64_v4i16((LAS v4i16_t*)(Kh_ + j * 4096 + vx[db][0])); \
                const v4i16_t hi_ = __builtin_amdgcn_ds_read_tr16_b64_v4i16((LAS v4i16_t*)(Kh_ + j * 4096 + vx[db][1])); \
                VF[j][db] = (bf16x8){lo_[0], lo_[1], lo_[2], lo_[3], hi_[0], hi_[1], hi_[2], hi_[3]}; } } while (0)
#define ATT_PVM(P, VF) do { bf16x8 pf_[2]; { u32x4 w_; \
              w_.x = cvtpk(P[0], P[1]); w_.y = cvtpk(P[2], P[3]); w_.z = cvtpk(P[4], P[5]); w_.w = cvtpk(P[6], P[7]); pf_[0] = __builtin_bit_cast(bf16x8, w_); \
              w_.x = cvtpk(P[8], P[9]); w_.y = cvtpk(P[10], P[11]); w_.z = cvtpk(P[12], P[13]); w_.w = cvtpk(P[14], P[15]); pf_[1] = __builtin_bit_cast(bf16x8, w_); } \
            _Pragma("unroll") for (int j = 0; j < 2; ++j) _Pragma("unroll") for (int db = 0; db < 4; ++db) O[db] = __builtin_amdgcn_mfma_f32_32x32x16_bf16(VF[j][db], pf_[j], O[db], 0, 0, 0); } while (0)
#define ATT_SB(P, b2) do { const int k0_ = 64 * kt + 32 * (b2), trel_ = (tw + r32) - k0_; float st[16]; \
            _Pragma("unroll") for (int r = 0; r < 16; ++r) { const float e_ = __builtin_amdgcn_exp2f(fminf(P[r] * (QSCALE * LOG2E), 60.0f)); st[r] = __builtin_amdgcn_rcpf(1.0f + e_); P[r] = e_; } \
            if (k0_ + 31 >= tw) {   \
                _Pragma("unroll") for (int r = 0; r < 16; ++r) { const int ko_ = 16 * (r >> 3) + 8 * hi + (r & 7); if (!(ko_ < trel_)) { st[r] = 1.0f; P[r] = 0.f; } } } \
            _Pragma("unroll") for (int r = 6; r >= 0; --r) { st[r] *= st[r + 1]; st[r + 8] *= st[r + 9]; } \
            const float A_ = st[0], B_ = st[8]; const float Ap_ = partner(A_, hi), Bp_ = partner(B_, hi); \
            const float cA_ = carry * (hi ? (Bp_ * B_) : (Ap_ * B_ * Bp_)), cB_ = carry * (hi ? 1.0f : Bp_); \
            _Pragma("unroll") for (int r = 0; r < 8; ++r) { P[r] = (P[r] * st[r]) * cA_; P[r + 8] = (P[r + 8] * st[r + 8]) * cB_; } \
            carry *= (A_ * B_) * (Ap_ * Bp_); } while (0)
#define ATT_CB(P, b2) do { const int trel_ = (tw + r32) - (64 * kt + 32 * (b2)); const LAS float* RKb_ = RK + it * 64 + 32 * (b2) + 8 * hi; float mx_; \
            { const f32x4 r0_ = *(const LAS f32x4*)(RKb_), r1_ = *(const LAS f32x4*)(RKb_ + 4), r2_ = *(const LAS f32x4*)(RKb_ + 16), r3_ = *(const LAS f32x4*)(RKb_ + 20); float bs_[16]; \
              if ((cw - kt) >= 5) { const float bc_ = TAB[0]; _Pragma("unroll") for (int r = 0; r < 16; ++r) bs_[r] = bc_; } \
              else { const LAS float* PTl_ = TAB + (256 + 63 - trel_ + 8 * hi); _Pragma("unroll") for (int r = 0; r < 16; ++r) bs_[r] = PTl_[16 * (r >> 3) + (r & 7)]; } \
              _Pragma("unroll") for (int e = 0; e < 4; ++e) { P[e] = __builtin_fmaf(P[e], r0_[e], bs_[e]); P[4 + e] = __builtin_fmaf(P[4 + e], r1_[e], bs_[4 + e]); P[8 + e] = __builtin_fmaf(P[8 + e], r2_[e], bs_[8 + e]); P[12 + e] = __builtin_fmaf(P[12 + e], r3_[e], bs_[12 + e]); } \
              float m0_ = fmaxf(fmaxf(P[0], P[1]), P[2]), m1_ = fmaxf(fmaxf(P[3], P[4]), P[5]); \
              m0_ = fmaxf(fmaxf(m0_, P[6]), P[7]); m1_ = fmaxf(fmaxf(m1_, P[8]), P[9]); m0_ = fmaxf(fmaxf(m0_, P[10]), P[11]); m1_ = fmaxf(fmaxf(m1_, P[12]), P[13]); \
              mx_ = fmaxf(fmaxf(m0_, m1_), fmaxf(P[14], P[15])); } \
            mx_ = fmaxf(mx_, partner(mx_, hi)); \
            if (__any(mx_ > mrun + 8.0f)) { const float mn_ = fmaxf(mrun, mx_), al_ = __builtin_amdgcn_exp2f(mrun - mn_); lrun *= al_; mrun = mn_; \
                _Pragma("unroll") for (int i = 0; i < 4; ++i) _Pragma("unroll") for (int r = 0; r < 16; ++r) O[i][r] *= al_; } \
            float ls_ = 0.f; _Pragma("unroll") for (int r = 0; r < 16; ++r) { P[r] = __builtin_amdgcn_exp2f(P[r] - mrun); ls_ += P[r]; } \
            lrun += ls_; } while (0)
        const bool relevant = (MODE == 0) ? (64 * kt <= tw + 30 && !wdone) : (kt >= cw - 8 && kt <= cw);
        if (relevant) {
            constexpr int bA = (MODE == 0) ? 1 : 0, bB = 1 - bA;
            f32x16 pA = f32x16{}, pB = f32x16{}; bf16x8 kA[8], kB[8], vA[2][4], vB[2][4];
            ATT_KLOAD(kA, bA); ATT_SBAR();
            __builtin_amdgcn_s_setprio(1);
            { const LAS unsigned char* Kh_ = Kb + bB * 8192;
#pragma unroll
              for (int d0 = 0; d0 < 8; ++d0) { pA = __builtin_amdgcn_mfma_f32_32x32x16_bf16(kA[d0], qf[d0], pA, 0, 0, 0); kB[d0] = *(const LAS bf16x8*)(Kh_ + kx[d0]); } }
            ATT_SBAR();
            ATT_VLOAD(vA, bA);
#pragma unroll
            for (int d0 = 0; d0 < 8; ++d0) pB = __builtin_amdgcn_mfma_f32_32x32x16_bf16(kB[d0], qf[d0], pB, 0, 0, 0);
            __builtin_amdgcn_s_setprio(0);
            ATT_SBAR();
            if (MODE == 0) ATT_SB(pA, bA); else ATT_CB(pA, bA);
            ATT_SBAR();
            __builtin_amdgcn_s_setprio(1); ATT_PVM(pA, vA); __builtin_amdgcn_s_setprio(0); ATT_VLOAD(vB, bB); ATT_SBAR();
            if (MODE == 0) ATT_SB(pB, bB); else ATT_CB(pB, bB);
            ATT_SBAR();
            __builtin_amdgcn_s_setprio(1); ATT_PVM(pB, vB); __builtin_amdgcn_s_setprio(0);
        }
#undef ATT_SBAR
#undef ATT_KLOAD
#undef ATT_QK2
#undef ATT_VLOAD
#undef ATT_PVM
#undef ATT_SB
#undef ATT_CB
        if (MODE == 0) { wdone = !__any(carry >= 0x1p-100f); if (lane == 0) FLG[(it & 1) * 8 + wid] = wdone ? 1u : 0u; }
        if (it + 2 < ntile) asm volatile("s_waitcnt vmcnt(4) lgkmcnt(0)" ::: "memory"); else asm volatile("s_waitcnt vmcnt(0) lgkmcnt(0)" ::: "memory");
        __builtin_amdgcn_s_barrier();
        asm volatile("" ::: "memory");
        if (MODE == 0) { const u32x4 fa = *(const LAS u32x4*)(FLG + (it & 1) * 8), fb = *(const LAS u32x4*)(FLG + (it & 1) * 8 + 4);
            if ((fa.x & fa.y & fa.z & fa.w & fb.x & fb.y & fb.z & fb.w) != 0u) break; }
        cur = nx1;
    }
#undef ATT_DMA
    asm volatile("s_waitcnt vmcnt(0) lgkmcnt(0)" ::: "memory");
    __builtin_amdgcn_s_barrier();
    asm volatile("" ::: "memory");
    float inv = 1.0f;
    if (MODE == 1) { lrun += partner(lrun, hi); inv = 1.0f / lrun; }
    LAS unsigned char* stg = lds + wid * (32 * 272);
    { const bf16* gbase = pg + (rowb + tw) * HD; u32x4 gr[8];
#pragma unroll
      for (int i = 0; i < 8; ++i) gr[i] = *(const u32x4*)(gbase + (size_t)(4 * i + (lane >> 4)) * HD + (lane & 15) * 8);
#pragma unroll
      for (int i = 0; i < 8; ++i) *(LAS u32x4*)(stg + (4 * i + (lane >> 4)) * 272 + (lane & 15) * 16) = gr[i]; }
    asm volatile("s_waitcnt lgkmcnt(0)" ::: "memory");
    u32x2 gv[4][4];
#pragma unroll
    for (int db = 0; db < 4; ++db)
#pragma unroll
        for (int rg = 0; rg < 4; ++rg) gv[db][rg] = *(const LAS u32x2*)(stg + r32 * 272 + (32 * db + 8 * rg + 4 * hi) * 2);
    asm volatile("s_waitcnt lgkmcnt(0)" ::: "memory");
#pragma unroll
    for (int db = 0; db < 4; ++db)
#pragma unroll
        for (int rg = 0; rg < 4; ++rg) {
            const u32x2 g = gv[db][rg];
            u32x2 o; o.x = cvtpk(O[db][4 * rg + 0] * inv * bflo(g.x), O[db][4 * rg + 1] * inv * bfhi(g.x));
            o.y = cvtpk(O[db][4 * rg + 2] * inv * bflo(g.y), O[db][4 * rg + 3] * inv * bfhi(g.y));
            *(LAS u32x2*)(stg + r32 * 272 + (32 * db + 8 * rg + 4 * hi) * 2) = o;
        }
    asm volatile("s_waitcnt lgkmcnt(0)" ::: "memory");
    bf16* obase = mix + (rowb + tw) * DM + mcol;
#pragma unroll
    for (int i = 0; i < 8; ++i) { const int row = 4 * i + (lane >> 4), ch = lane & 15;
        const u32x4 v = *(const LAS u32x4*)(stg + row * 272 + ch * 16);
        asm volatile("global_store_dwordx4 %0, %1, off sc1\n\ts_nop 1" :: "v"(obase + (size_t)row * DM + ch * 8), "v"(v) : "memory"); }
    asm volatile("s_waitcnt vmcnt(0)" ::: "memory");
    __syncthreads();
    if (tid == 0) __hip_atomic_fetch_add(cnt, 1u, __ATOMIC_RELAXED, __HIP_MEMORY_SCOPE_AGENT);
}

__device__ __forceinline__ void decode(int x, int e, int& mode, int& bh, int& blk) {
    bh = 4 * x + (e & 3); const int g = e >> 2;
    if (g < 6) { mode = 1; blk = 7 - g; return; }
    if (g == 6) { mode = 1; blk = 1; return; }
    if (g < 14) { mode = 0; blk = 14 - g; return; }
    if (g == 14) { mode = 1; blk = 0; return; }
    mode = 0; blk = 0;
}
__device__ __forceinline__ void phase(LAS unsigned char* lds, unsigned* heads, unsigned* cnts, int myx, const bf16* proj, bf16* mix, const float* qg, const float* kg, const float* rel, const float* kn) {
    LAS int* slot = (LAS int*)(lds + OFF_QIDX);
    int t1_ = threadIdx.x; asm volatile("" : "+v"(t1_));
    const int lane = t1_ & 63, wid = __builtin_amdgcn_readfirstlane(t1_ >> 6);
    int x = myx & 7, par = 0;
    for (;;) {
        if (wid == 0) {
            int e = -1;
            for (;;) {
                unsigned v = 64u; if (lane == 0) v = __hip_atomic_fetch_add(heads + 64 * x, 1u, __ATOMIC_RELAXED, __HIP_MEMORY_SCOPE_AGENT);
                v = (unsigned)__builtin_amdgcn_readfirstlane((int)v);
                if (v < 64u) { e = (int)v; break; }
                unsigned h = 64u; if (lane < 8) h = __hip_atomic_load(heads + 64 * lane, __ATOMIC_RELAXED, __HIP_MEMORY_SCOPE_AGENT);
                const unsigned long long m = __ballot(h < 64u);
                if (m == 0ull) break;
                const unsigned m8 = (unsigned)m & 0xffu, rot = ((m8 >> x) | (m8 << (8 - x))) & 0xffu;
                x = (x + __builtin_ctz(rot)) & 7;
            }
            if (lane == 0) { slot[2 * par] = e; slot[2 * par + 1] = x; }
        }
        __syncthreads();
        const int e = __builtin_amdgcn_readfirstlane(slot[2 * par]), xq = __builtin_amdgcn_readfirstlane(slot[2 * par + 1]);
        par ^= 1;
        if (e < 0) break;
        int mode, bh, blk; decode(xq, e, mode, bh, blk);
        unsigned* cnt = cnts + ((bh >> 3) * 8 + blk) * 16;
        if (mode == 0) unit<0>(lds, proj, mix, bh >> 3, bh & 7, blk, qg, kg, rel, kn, cnt);
        else unit<1>(lds, proj, mix, bh >> 3, bh & 7, blk, qg, kg, rel, kn, cnt);
    }
}
}

__device__ __forceinline__ int draw32(unsigned* base, int stride, int& x, int lane) {
    for (;;) {
        unsigned v = 32u; if (lane == 0) v = __hip_atomic_fetch_add(base + stride * x, 1u, __ATOMIC_RELAXED, __HIP_MEMORY_SCOPE_AGENT);
        v = (unsigned)__builtin_amdgcn_readfirstlane((int)v);
        if (v < 32u) return (int)v;
        unsigned hh = 32u; if (lane < 8) hh = __hip_atomic_load(base + stride * lane, __ATOMIC_RELAXED, __HIP_MEMORY_SCOPE_AGENT);
        const unsigned long long m = __ballot(hh < 32u);
        if (m == 0ull) return -1;
        const unsigned m8 = (unsigned)m & 0xffu, rot = ((m8 >> x) | (m8 << (8 - x))) & 0xffu;
        x = (x + __builtin_ctz(rot)) & 7;
    }
}

struct Args { const float* x; const float* norm_g; const float* w_in; const float* qg; const float* kg; const float* rel; const float* w_out; float* out; unsigned char* ws; int cg_sync; int pad; };

__global__ void __launch_bounds__(512, 2) fwd_megakernel(Args a) {
    extern __shared__ __attribute__((aligned(16))) unsigned char lds_raw[];
    cg::grid_group grid = cg::this_grid();
    LAS unsigned char* lds = (LAS unsigned char*)lds_raw;
    const int tid = threadIdx.x, lane = tid & 63, wave = __builtin_amdgcn_readfirstlane(tid >> 6);
    const int G = gridDim.x, gw = blockIdx.x * 8 + wave, ngw = G * 8;
    unsigned* ctl = (unsigned*)(a.ws + WS_CTL);
    if (tid < 2) ((LAS unsigned*)(lds + MISC_OFF))[tid] = 0u;
    __syncthreads();
    const XcdBarrier bar = xcd_barrier_post(ctl + CW_BAR, (volatile LAS unsigned*)(lds + MISC_OFF));
    bf16* WIN = (bf16*)(a.ws + WS_WIN); bf16* WOUT = (bf16*)(a.ws + WS_WOUT); bf16* XN = (bf16*)(a.ws + WS_XN); float* SSQ = (float*)(a.ws + WS_SSQ); float* KN0 = (float*)(a.ws + WS_KN); bf16* PROJ0 = (bf16*)(a.ws + WS_PROJ); bf16* MIX = (bf16*)(a.ws + WS_MIX);

    {
        LAS float* scr = (LAS float*)(lds + wave * 16384);
        constexpr int I_IN = (DM / 64) * (DIN / 32), I_OUT = (DM / 64) * (DM / 32), I_L = I_IN + I_OUT;
        for (int it = gw; it < DEPTH * I_L; it += ngw) {
            const int l = DEPTH - 1 - it / I_L, r = it % I_L;
            if (r < I_IN) transpose_item(a.w_in + (size_t)l * DM * DIN, a.norm_g + (size_t)l * DM, DM, DIN, WIN + (size_t)l * DIN * DM, scr, r, lane);
            else transpose_item(a.w_out + (size_t)l * DM * DM, nullptr, DM, DM, WOUT + (size_t)l * DM * DM, scr, r - I_IN, lane);
        }
        cast_rows(a.x, XN, SSQ, gw, ngw, lane);
    }
    if (a.cg_sync) grid.sync();
    grid_barrier(bar);
    for (int l = 0; l < DEPTH; ++l) {
        bf16* PROJ = (l & 1) ? (bf16*)(a.ws + WS_PROJ1) : PROJ0; float* KN = (l & 1) ? (float*)(a.ws + WS_KN1) : KN0;
        int Gl = G, bx = (int)blockIdx.x; asm volatile("" : "+s"(Gl), "+s"(bx));
        { pg8::Gemm g{XN, WIN + (size_t)l * DIN * DM, MTOK, DIN, DM};
          LAS float* RSL = (LAS float*)(lds + RS_OFF);
          int t3 = threadIdx.x; asm volatile("" : "+v"(t3));
          int so1 = RS_OFF; asm volatile("" : "+s"(so1)); LAS int* slot1 = (LAS int*)(lds + so1);
          int xs1 = (int)bar.x & 7; asm volatile("" : "+s"(xs1));
          if (t3 < 64) { int x = xs1; const int e = draw32(ctl + 512 * l + 16, 64, x, t3); if (t3 == 0) { slot1[0] = e; slot1[1] = x; } }
          __syncthreads();
          const int e1 = __builtin_amdgcn_readfirstlane(slot1[0]), x1 = __builtin_amdgcn_readfirstlane(slot1[1]);
          __syncthreads();
          if (e1 >= 0) {
          const int pm1 = 8 * (x1 >> 1) + 7 - (e1 >> 2);
          pg8::QuadOrder S{pm1, x1 & 1, e1 & 3, l > 0 ? (const unsigned*)(ctl + CW_CNT + ((l - 1) * 32 + pm1) * 16) : nullptr, SSQ, RSL};
          pg8::EpiProj E{PROJ, MTOK, RSL, KN};
          pg8::gemm_phase<pg8::EpiProj, pg8::QuadOrder, true, true>(lds, g, S, E); } }
        grid_barrier(bar);
        att::phase(lds, ctl + 512 * l, ctl + CW_CNTA + l * 512, (int)bar.x, PROJ, MIX, a.qg + l * HD, a.kg + l * HD, a.rel + (size_t)l * NH * NREL, KN);
        { pg8::Gemm g{MIX, WOUT + (size_t)l * DM * DM, MTOK, DM, DM};
          int t4 = threadIdx.x; asm volatile("" : "+v"(t4));
          int so3 = RS_OFF; asm volatile("" : "+s"(so3)); LAS int* slot3 = (LAS int*)(lds + so3);
          int xs3 = (int)bar.x & 7; asm volatile("" : "+s"(xs3));
          if (t4 < 64) { int x = xs3; const int e = draw32(ctl + 3584 + l * 128, 16, x, t4); if (t4 == 0) { slot3[0] = e; slot3[1] = x; } }
          __syncthreads();
          const int e3 = __builtin_amdgcn_readfirstlane(slot3[0]), x3 = __builtin_amdgcn_readfirstlane(slot3[1]);
          if (e3 >= 0) {
          const int pm3 = 8 * (x3 >> 1) + 7 - (e3 >> 2);
          pg8::OneUnit S{pm3, 4 * (x3 & 1) + (e3 & 3), (const unsigned*)(ctl + CW_CNTA + l * 512 + pm3 * 16), 16u};
          pg8::EpiRes E{a.out, XN, SSQ, DM, l == DEPTH - 1};
          pg8::gemm_phase<pg8::EpiRes, pg8::OneUnit, true, true>(lds, g, S, E);
          if (threadIdx.x == 0 && l + 1 < DEPTH) __hip_atomic_fetch_add(ctl + CW_CNT + (l * 32 + S.pm) * 16, 1u, __ATOMIC_RELAXED, __HIP_MEMORY_SCOPE_AGENT); } }
    }
}

extern "C" void kernel_launch(void* const* d_in, const int* in_sizes, int n_in, void* d_out, int out_size, void* d_ws, size_t ws_size, hipStream_t stream) {
    static int grid_blocks = 0;
    if (grid_blocks == 0) {
        if (n_in != 7 || out_size != MTOK * DM || ws_size < WS_END) { fprintf(stderr, "kernel_launch: unexpected shapes (n_in %d out %d ws %zu)\n", n_in, out_size, ws_size); grid_blocks = -1; return; }
        int dev = 0, cus = 0, per_cu = 0;
        (void)hipGetDevice(&dev);
        (void)hipDeviceGetAttribute(&cus, hipDeviceAttributeMultiprocessorCount, dev);
        (void)hipFuncSetAttribute((const void*)fwd_megakernel, hipFuncAttributeMaxDynamicSharedMemorySize, LDS_BYTES);
        (void)hipOccupancyMaxActiveBlocksPerMultiprocessor(&per_cu, (const void*)fwd_megakernel, 512, LDS_BYTES);
        if (per_cu < 1) { fprintf(stderr, "kernel_launch: occupancy query says %d blocks per CU\n", per_cu); per_cu = 1; }
        (void)hipGetLastError();
        if (cus * per_cu < 256) fprintf(stderr, "kernel_launch: the device reports %d CUs x %d resident blocks; this kernel's phase maps assume a 256-workgroup grid (MI355X)\n", cus, per_cu);
        grid_blocks = 256;
    }
    if (grid_blocks < 0) return;
    (void)hipMemsetAsync((char*)d_ws + WS_CTL, 0, CTL_ZERO_BYTES, stream);
    Args a{};
    a.x = (const float*)d_in[0]; a.norm_g = (const float*)d_in[1]; a.w_in = (const float*)d_in[2]; a.qg = (const float*)d_in[3]; a.kg = (const float*)d_in[4];
    a.rel = (const float*)d_in[5]; a.w_out = (const float*)d_in[6]; a.out = (float*)d_out; a.ws = (unsigned char*)d_ws;
    void* args[] = {&a};
    hipError_t e = hipLaunchCooperativeKernel((const void*)fwd_megakernel, dim3(grid_blocks), dim3(512), args, LDS_BYTES, stream);
    if (e != hipSuccess) fprintf(stderr, "cooperative launch failed: %s (grid %d)\n", hipGetErrorString(e), grid_blocks);
}
```

```cpp
#include <hip/hip_runtime.h>
#include <hip/hip_cooperative_groups.h>
#include <cstdio>
#include <cstdint>
namespace cg = cooperative_groups;
namespace pg8 {
#define PG8_LAS __attribute__((address_space(3)))
typedef unsigned short bf16_t;
typedef short bf16x8 __attribute__((ext_vector_type(8)));
typedef float f32x4 __attribute__((ext_vector_type(4)));
typedef unsigned u32x4 __attribute__((ext_vector_type(4)));
constexpr int BM = 256, BK = 64, HALF = 128, HTB = HALF * BK * 2  , STAGE_BYTES = 8 * HTB, NXCD = 8, WGM = 8;

__host__ __device__ __forceinline__ int lds_byte(int r, int c) { const int st = (r >> 4) * 2 + (c >> 5), rr = r & 15, cc = c & 31, ob = rr * 64 + cc * 2; return st * 1024 + (ob ^ (((ob >> 9) & 1) << 5)); }
__host__ __device__ __forceinline__ void stage_rc(int b, int& R, int& C) { const int st = b / 1024, sb = b % 1024, swz = sb ^ (((sb >> 9) & 1) << 5); R = (st >> 1) * 16 + swz / 64; C = (st & 1) * 32 + (swz % 64) / 2; }
__host__ __device__ __forceinline__ int perm32(int rho) { const int n = rho >> 4, i = rho & 15; return 8 * (i >> 2) + 4 * n + (i & 3); }

struct Unit { int pm, pn, ui; };
struct Gemm { const bf16_t* A; const bf16_t* Bt; int M, N, K; };

struct StaticOrder {
    int nM, nN, nwg, G, c, hmap;
    __host__ __device__ void init(int M, int N, int G_, int c_) { nM = M / BM; nN = N / BM; nwg = nM * nN; G = G_; c = c_; hmap = 0; }
    __host__ __device__ bool next(int i, Unit& u) const {
        const long L = (long)i * G + c; if (L >= nwg) return false;
        int wgid = (int)L; { const int q = nwg / NXCD, r = nwg % NXCD, xcd = wgid % NXCD, off = wgid / NXCD; wgid = (xcd < r ? xcd * (q + 1) : r * (q + 1) + (xcd - r) * q) + off; }
        const int nig = WGM * nN, gid = wgid / nig, fm = gid * WGM, gsz = (nM - fm) < WGM ? (nM - fm) : WGM;
        u.pm = fm + ((wgid % nig) % gsz); u.pn = (wgid % nig) / gsz; u.ui = i;
        if (hmap) { const int s = u.pn >> 4, j = u.pn & 15; u.pn = 4 * (j >> 1) + 2 * s + (j & 1); }
        return true;
    }
    __device__ __forceinline__ void a_ready(const Unit&) const {}
    __device__ __forceinline__ void done(const Unit&) const {}
};
struct OneUnit {
    int pm, pn; const unsigned* ready; unsigned need;
    __device__ __forceinline__ bool next(int i, Unit& u) const { if (i) return false; u.pm = pm; u.pn = pn; u.ui = 0; return true; }
    __device__ __forceinline__ void a_ready(const Unit&) const {
        int t_ = threadIdx.x; asm volatile("" : "+v"(t_));
        if (t_ < 64) { unsigned sp = 0;
            while ((unsigned)__builtin_amdgcn_readfirstlane((int)__hip_atomic_load(ready, __ATOMIC_RELAXED, __HIP_MEMORY_SCOPE_AGENT)) < need) { __builtin_amdgcn_s_sleep(2); if (++sp > (1u << 22)) break; }
            __builtin_amdgcn_fence(__ATOMIC_ACQUIRE, "agent");
            asm volatile("s_waitcnt vmcnt(0)" ::: "memory"); }
        asm volatile("" ::: "memory"); __builtin_amdgcn_s_barrier(); asm volatile("" ::: "memory");
    }
    __device__ __forceinline__ void done(const Unit&) const {}
};
struct QuadOrder {
    int pm, s, k;
    __device__ __forceinline__ bool next(int i, Unit& u) const { if (i >= 4) return false; const int j = 4 * i + k; u.pm = pm; u.pn = 4 * (j >> 1) + 2 * s + (j & 1); u.ui = i; return true; }
    __device__ __forceinline__ void a_ready(const Unit&) const {}
    __device__ __forceinline__ void done(const Unit&) const {}
};
__device__ __forceinline__ unsigned cvt_pk_bf16(float lo, float hi) { unsigned r; asm volatile("v_cvt_pk_bf16_f32 %0, %1, %2" : "=v"(r) : "v"(lo), "v"(hi)); return r; }
typedef float f32x2 __attribute__((ext_vector_type(2)));
typedef unsigned u32x4e __attribute__((ext_vector_type(4)));
__device__ __forceinline__ float shfl_xor_l(float v, int lane, int mask) { return __builtin_bit_cast(float, __builtin_amdgcn_ds_bpermute((lane ^ mask) << 2, __builtin_bit_cast(int, v))); }
__device__ __forceinline__ float silu_f(float v) { return v * __builtin_amdgcn_rcpf(1.0f + __builtin_amdgcn_exp2f(-1.4426950408889634f * v)); }
struct EpiProj {
    static constexpr bool PERM = true, AFTER_DRAIN = false;
    bf16_t* O; int mtok; const PG8_LAS float* rs; float* kn;
    __device__ __forceinline__ void operator()(const f32x4 (&acc)[2][2][4][2], const Unit& u, int wr, int wc, int fr, int fq) const {
        const int row0 = u.pm * BM + wr * 64 + fr;
        bf16_t* Oh = O + ((size_t)((u.pn >> 2) * 8 + 2 * (u.pn & 3)) * mtok) * 128 + wc * 32 + 8 * fq;
        const PG8_LAS float* rsu = rs + u.ui * BM + wr * 64 + fr;
        const int grp = u.pn >> 2; const bool gate = (grp & 3) == 3, qk = (grp == 4) || (grp == 5);
        float sq[2][4][2];
#pragma unroll
        for (int ai = 0; ai < 2; ++ai)
#pragma unroll
            for (int m = 0; m < 4; ++m) { bf16_t* rowp = Oh + (size_t)(row0 + ai * HALF + m * 16) * 128; const float rsc = rsu[ai * HALF + m * 16];
#pragma unroll
                for (int bj = 0; bj < 2; ++bj) { f32x4 v0 = acc[ai][bj][m][0] * rsc, v1 = acc[ai][bj][m][1] * rsc;
                    if (gate) { v0 = (f32x4){silu_f(v0[0]), silu_f(v0[1]), silu_f(v0[2]), silu_f(v0[3])}; v1 = (f32x4){silu_f(v1[0]), silu_f(v1[1]), silu_f(v1[2]), silu_f(v1[3])}; }
                    sq[ai][m][bj] = (v0[0] * v0[0] + v0[1] * v0[1]) + (v0[2] * v0[2] + v0[3] * v0[3]) + (v1[0] * v1[0] + v1[1] * v1[1]) + (v1[2] * v1[2] + v1[3] * v1[3]);
                    u32x4e w; w.x = cvt_pk_bf16(v0[0], v0[1]); w.y = cvt_pk_bf16(v0[2], v0[3]); w.z = cvt_pk_bf16(v1[0], v1[1]); w.w = cvt_pk_bf16(v1[2], v1[3]);
                    *(u32x4e*)(rowp + (size_t)bj * mtok * 128) = w; } }
        if (qk) {
            const int hq = (grp - 4) * 8 + 2 * (u.pn & 3);
#pragma unroll
            for (int ai = 0; ai < 2; ++ai)
#pragma unroll
                for (int m = 0; m < 4; ++m)
#pragma unroll
                    for (int bj = 0; bj < 2; ++bj) { float s = sq[ai][m][bj]; s += shfl_xor_l(s, fq * 16 + fr, 16); s += shfl_xor_l(s, fq * 16 + fr, 32);
                        if (fq == 0) kn[((size_t)(hq + bj) * (BM * 32) + (row0 + ai * HALF + m * 16)) * 4 + wc] = s; }
        }
    }
};
struct EpiRes {
    static constexpr bool PERM = true, AFTER_DRAIN = false;
    float* out; bf16_t* xb; float* ssq; int ldc; int last;
    __device__ __forceinline__ void operator()(const f32x4 (&acc)[2][2][4][2], const Unit& u, int wr, int wc, int fr, int fq) const {
        const int row0 = u.pm * BM + wr * 64 + fr; const int col0 = u.pn * BM + wc * 32 + 8 * fq;
        float sq[2][4];
#pragma unroll
        for (int ai = 0; ai < 2; ++ai) {
            u32x4e bv[4][2];
#pragma unroll
            for (int m = 0; m < 4; ++m) { const size_t off = (size_t)(row0 + ai * HALF + m * 16) * ldc + col0;
#pragma unroll
                for (int bj = 0; bj < 2; ++bj) bv[m][bj] = *(const u32x4e*)(xb + off + bj * HALF); }
#pragma unroll
            for (int m = 0; m < 4; ++m) { const size_t off = (size_t)(row0 + ai * HALF + m * 16) * ldc + col0; float s = 0.f;
#pragma unroll
                for (int bj = 0; bj < 2; ++bj) {
                    const u32x4e b = bv[m][bj];
                    const f32x4 x0 = (f32x4){__builtin_bit_cast(float, b.x << 16), __builtin_bit_cast(float, b.x & 0xffff0000u), __builtin_bit_cast(float, b.y << 16), __builtin_bit_cast(float, b.y & 0xffff0000u)} + acc[ai][bj][m][0];
                    const f32x4 x1 = (f32x4){__builtin_bit_cast(float, b.z << 16), __builtin_bit_cast(float, b.z & 0xffff0000u), __builtin_bit_cast(float, b.w << 16), __builtin_bit_cast(float, b.w & 0xffff0000u)} + acc[ai][bj][m][1];
                    if (last) { *(f32x4*)(out + off + bj * HALF) = x0; *(f32x4*)(out + off + bj * HALF + 4) = x1; }
                    else {
                        u32x4e w; w.x = cvt_pk_bf16(x0[0], x0[1]); w.y = cvt_pk_bf16(x0[2], x0[3]); w.z = cvt_pk_bf16(x1[0], x1[1]); w.w = cvt_pk_bf16(x1[2], x1[3]);
                        asm volatile("global_store_dwordx4 %0, %1, off sc1\n\ts_nop 1" :: "v"(xb + off + bj * HALF), "v"(w) : "memory");
                        s += (x0[0] * x0[0] + x0[1] * x0[1]) + (x0[2] * x0[2] + x0[3] * x0[3]) + (x1[0] * x1[0] + x1[1] * x1[1]) + (x1[2] * x1[2] + x1[3] * x1[3]); } }
                sq[ai][m] = s; }
            asm volatile("" ::: "memory");
        }
        if (last) return;
#pragma unroll
        for (int ai = 0; ai < 2; ++ai)
#pragma unroll
            for (int m = 0; m < 4; ++m) {
                const float s1 = sq[ai][m] + shfl_xor_l(sq[ai][m], fq * 16 + fr, 16);
                const float s2 = s1 + shfl_xor_l(s1, fq * 16 + fr, 32);
                if (fq == 0) __hip_atomic_store(ssq + (size_t)(row0 + ai * HALF + m * 16) * 32 + u.pn * 4 + wc, s2, __ATOMIC_RELAXED, __HIP_MEMORY_SCOPE_AGENT); }
    }
};
template <class Epi, class Sched, bool ALIGN_EPI = false, bool SP2 = false>
__device__ __forceinline__ void gemm_phase(PG8_LAS unsigned char* lds, const Gemm g, const Sched& S, const Epi& E) {
    int tid_ = threadIdx.x; asm volatile("" : "+v"(tid_));
    const int tid = tid_, wid = __builtin_amdgcn_readfirstlane(tid >> 6), lane = tid & 63, wr = wid >> 2, wc = wid & 3, fr = lane & 15, fq = lane >> 4;
    const int K = g.K, nt = K / BK;
    unsigned voffA[2], voffB[2];
#pragma unroll
    for (int i = 0; i < 2; ++i) { int R, C; stage_rc(tid * 16 + i * 8192, R, C); const int Rb = Epi::PERM ? ((R & ~31) + perm32(R & 31)) : R;
        voffA[i] = (unsigned)(R * K + C) * 2u; voffB[i] = (unsigned)(Rb * K + C) * 2u; }
    const size_t kstep = (size_t)(BK * 2);
    const size_t hstep = (size_t)HALF * K * 2;
    const size_t tstep = 2 * hstep;
    const unsigned ldsw = (unsigned)wid * 1024u;
    const int aoff = lds_byte(wr * 64 + fr, fq * 8), boff = lds_byte(wc * 32 + fr, fq * 8);
#define PG8_SA(b, h) (((b) * 2 + (h)) * HTB)
#define PG8_SB(b, h) ((4 + (b) * 2 + (h)) * HTB)
#define PG8_STAGE(bufoff, gbase, voff) do { _Pragma("unroll") for (int _i = 0; _i < 2; ++_i) \
        __builtin_amdgcn_global_load_lds((const unsigned*)((const char*)(gbase) + (voff)[_i]), (PG8_LAS unsigned*)(lds + (bufoff) + ldsw + _i * 8192), 16, 0, 0); } while (0)
#define PG8_LDA(dst, b, h) do { _Pragma("unroll") for (int m = 0; m < 4; ++m) _Pragma("unroll") for (int k = 0; k < 2; ++k) dst[m][k] = *(const PG8_LAS bf16x8*)(lds + PG8_SA(b, h) + aoff + m * 2048 + k * 1024); } while (0)
#define PG8_LDB(dst, b, h) do { _Pragma("unroll") for (int n = 0; n < 2; ++n) _Pragma("unroll") for (int k = 0; k < 2; ++k) dst[n][k] = *(const PG8_LAS bf16x8*)(lds + PG8_SB(b, h) + boff + n * 2048 + k * 1024); } while (0)
#define PG8_MMA(ai, bj, At, Bt) do { __builtin_amdgcn_s_setprio(1); _Pragma("unroll") for (int m = 0; m < 4; ++m) _Pragma("unroll") for (int n = 0; n < 2; ++n) _Pragma("unroll") for (int k = 0; k < 2; ++k) \
        acc[ai][bj][m][n] = __builtin_amdgcn_mfma_f32_16x16x32_bf16(Bt[n][k], At[m][k], acc[ai][bj][m][n], 0, 0, 0); __builtin_amdgcn_s_setprio(0); } while (0)
#define PG8_WAIT_V(n) asm volatile("s_waitcnt vmcnt(" #n ")" ::: "memory")
#define PG8_WAIT_L(n) asm volatile("s_waitcnt lgkmcnt(" #n ")" ::: "memory")
#define PG8_BAR __builtin_amdgcn_s_barrier()
#define PG8_SCHED __builtin_amdgcn_sched_barrier(0)
    Unit cur, nxt; int ui = 0;
    if (!S.next(0, cur)) return;
    f32x4 acc[2][2][4][2];
#pragma unroll
    for (int a = 0; a < 2; ++a)
#pragma unroll
        for (int b = 0; b < 2; ++b)
#pragma unroll
            for (int m = 0; m < 4; ++m)
#pragma unroll
                for (int n = 0; n < 2; ++n) acc[a][b][m][n] = (f32x4){0.f, 0.f, 0.f, 0.f};
    bf16x8 At[4][2], B0[2][2], B1[2][2];
    const char* cA = (const char*)g.A + (size_t)cur.pm * tstep; const char* cB = (const char*)g.Bt + (size_t)cur.pn * tstep;
    if constexpr (!SP2) S.a_ready(cur);
    if constexpr (SP2) {
        PG8_STAGE(PG8_SB(0, 0), cB, voffB); PG8_STAGE(PG8_SB(0, 1), cB + hstep, voffB);
        S.a_ready(cur);
        PG8_STAGE(PG8_SA(0, 0), cA, voffA); PG8_STAGE(PG8_SA(0, 1), cA + hstep, voffA);
        if (wr == 1) PG8_BAR;
        PG8_WAIT_V(2); PG8_BAR;
        PG8_STAGE(PG8_SB(1, 0), cB + kstep, voffB); PG8_STAGE(PG8_SA(1, 0), cA + kstep, voffA); PG8_STAGE(PG8_SB(1, 1), cB + hstep + kstep, voffB);
        PG8_WAIT_V(6); PG8_BAR;
    } else {
        PG8_STAGE(PG8_SB(0, 0), cB, voffB); PG8_STAGE(PG8_SA(0, 0), cA, voffA); PG8_STAGE(PG8_SB(0, 1), cB + hstep, voffB); PG8_STAGE(PG8_SA(0, 1), cA + hstep, voffA);
        if (wr == 1) PG8_BAR;
        PG8_WAIT_V(4); PG8_BAR;
        PG8_STAGE(PG8_SB(1, 0), cB + kstep, voffB); PG8_STAGE(PG8_SA(1, 0), cA + kstep, voffA); PG8_STAGE(PG8_SB(1, 1), cB + hstep + kstep, voffB);
        PG8_WAIT_V(6); PG8_BAR;
    }
    for (;;) {
        const bool has_next = S.next(ui + 1, nxt);
        const char* nA = has_next ? (const char*)g.A + (size_t)nxt.pm * tstep : cA; const char* nB = has_next ? (const char*)g.Bt + (size_t)nxt.pn * tstep : cB;
        for (int t = 0; t < nt; t += 2) {
            const bool last = (t == nt - 2);
            const char* a1 = cA + (size_t)(t + 1) * kstep;
            const char* a2 = last ? nA : cA + (size_t)(t + 2) * kstep; const char* b2 = last ? nB : cB + (size_t)(t + 2) * kstep;
            const char* a3 = a2 + kstep; const char* b3 = b2 + kstep;
            if (last && has_next) S.a_ready(nxt);
            if constexpr (SP2) {
            PG8_LDB(B0, 0, 0); PG8_LDB(B1, 0, 1); PG8_SCHED; PG8_LDA(At, 0, 0); PG8_STAGE(PG8_SA(1, 1), a1 + hstep, voffA);
            PG8_WAIT_V(8); PG8_WAIT_L(0); PG8_BAR; PG8_MMA(0, 0, At, B0); PG8_MMA(0, 1, At, B1); PG8_BAR; PG8_SCHED;
            PG8_LDA(At, 0, 1); PG8_STAGE(PG8_SB(0, 0), b2, voffB); PG8_STAGE(PG8_SB(0, 1), b2 + hstep, voffB); PG8_STAGE(PG8_SA(0, 0), a2, voffA);
            PG8_WAIT_V(8); PG8_WAIT_L(0); PG8_BAR; PG8_MMA(1, 0, At, B0); PG8_MMA(1, 1, At, B1); PG8_BAR; PG8_SCHED;
            PG8_LDB(B0, 1, 0); PG8_LDB(B1, 1, 1); PG8_SCHED; PG8_LDA(At, 1, 0); PG8_STAGE(PG8_SA(0, 1), a2 + hstep, voffA);
            PG8_WAIT_V(8); PG8_WAIT_L(0); PG8_BAR; PG8_MMA(0, 0, At, B0); PG8_MMA(0, 1, At, B1); PG8_BAR; PG8_SCHED;
            PG8_LDA(At, 1, 1); PG8_STAGE(PG8_SB(1, 0), b3, voffB); PG8_STAGE(PG8_SB(1, 1), b3 + hstep, voffB); PG8_STAGE(PG8_SA(1, 0), a3, voffA);
            PG8_WAIT_V(8); PG8_WAIT_L(0); PG8_BAR; PG8_MMA(1, 0, At, B0); PG8_MMA(1, 1, At, B1); PG8_BAR; PG8_SCHED;
            } else {
            PG8_LDB(B0, 0, 0); PG8_SCHED; PG8_LDA(At, 0, 0); PG8_STAGE(PG8_SA(1, 1), a1 + hstep, voffA);
            PG8_WAIT_L(8); PG8_BAR; PG8_WAIT_L(0); PG8_MMA(0, 0, At, B0); PG8_BAR; PG8_SCHED;
            PG8_LDB(B1, 0, 1); PG8_STAGE(PG8_SB(0, 0), b2, voffB);
            PG8_BAR; PG8_WAIT_L(0); PG8_MMA(0, 1, At, B1); PG8_BAR;
            PG8_LDA(At, 0, 1); PG8_STAGE(PG8_SA(0, 0), a2, voffA);
            PG8_BAR; PG8_WAIT_L(0); PG8_MMA(1, 0, At, B0); PG8_BAR; PG8_SCHED;
            PG8_STAGE(PG8_SB(0, 1), b2 + hstep, voffB);
            PG8_WAIT_V(6); PG8_BAR; PG8_MMA(1, 1, At, B1); PG8_BAR;
            PG8_LDB(B0, 1, 0); PG8_SCHED; PG8_LDA(At, 1, 0); PG8_STAGE(PG8_SA(0, 1), a2 + hstep, voffA);
            PG8_WAIT_L(8); PG8_BAR; PG8_WAIT_L(0); PG8_MMA(0, 0, At, B0); PG8_BAR; PG8_SCHED;
            PG8_LDB(B1, 1, 1); PG8_STAGE(PG8_SB(1, 0), b3, voffB);
            PG8_BAR; PG8_WAIT_L(0); PG8_MMA(0, 1, At, B1); PG8_BAR;
            PG8_LDA(At, 1, 1); PG8_STAGE(PG8_SA(1, 0), a3, voffA);
            PG8_BAR; PG8_WAIT_L(0); PG8_MMA(1, 0, At, B0); PG8_BAR; PG8_SCHED;
            PG8_STAGE(PG8_SB(1, 1), b3 + hstep, voffB);
            PG8_WAIT_V(6); PG8_BAR; PG8_MMA(1, 1, At, B1); PG8_BAR;
            }
        }
        if constexpr (ALIGN_EPI) { if (wr == 0) PG8_BAR; }
        if constexpr (!Epi::AFTER_DRAIN) { E(acc, cur, wr, wc, fr, fq); S.done(cur); }
        if (!has_next) break;
#pragma unroll
        for (int a = 0; a < 2; ++a)
#pragma unroll
            for (int b = 0; b < 2; ++b)
#pragma unroll
                for (int m = 0; m < 4; ++m)
#pragma unroll
                    for (int n = 0; n < 2; ++n) acc[a][b][m][n] = (f32x4){0.f, 0.f, 0.f, 0.f};
        cur = nxt; cA = nA; cB = nB; ++ui;
        if constexpr (ALIGN_EPI) { if (wr == 1) PG8_BAR; }
    }
    PG8_WAIT_V(0);
    if constexpr (!ALIGN_EPI) { if (wr == 0) PG8_BAR; }
    PG8_BAR;
    if constexpr (Epi::AFTER_DRAIN) { E.fused(acc, cur, wr, wc, fr, fq, lds, wid, lane); S.done(cur); }
#undef PG8_SA
#undef PG8_SB
#undef PG8_STAGE
#undef PG8_LDA
#undef PG8_LDB
#undef PG8_MMA
#undef PG8_WAIT_V
#undef PG8_WAIT_L
#undef PG8_BAR
#undef PG8_SCHED
}
}
constexpr int BATCH = 4, SEQ = 2048, DM = 2048, DEPTH = 4, HD = 128, NH = 8, DIN = 8192, MTOK = BATCH * SEQ, NREL = 320;
constexpr float EPS = 1e-6f, LOG2E = 1.4426950408889634f, QSCALE = 0.08838834764831845f;
constexpr size_t MiB = 1u << 20;
constexpr size_t WS_CTL = 0, WS_WIN = 1 * MiB, WS_WOUT = 129 * MiB, WS_XN = 161 * MiB, WS_PROJ = 193 * MiB, WS_MIX = 321 * MiB, WS_SSQ = 353 * MiB, WS_KN = 354 * MiB, WS_PROJ1 = 356 * MiB, WS_KN1 = 484 * MiB, WS_END = 486 * MiB;
constexpr int LDS_BYTES = 139264, RS_OFF = 131072, MISC_OFF = 135168 + 1024;
constexpr int CW_BAR = 6144, CW_CNT = 2048, CW_CNTA = 4096, CTL_ZERO_BYTES = 40960;
constexpr int LDS_BYTES_ = 135168;

#define LAS __attribute__((address_space(3)))
typedef unsigned short bf16;
typedef short bf16x8 __attribute__((ext_vector_type(8)));
typedef short v4i16_t __attribute__((ext_vector_type(4)));
typedef float f32x4 __attribute__((ext_vector_type(4)));
typedef float f32x16 __attribute__((ext_vector_type(16)));
typedef unsigned u32x4 __attribute__((ext_vector_type(4)));
typedef unsigned u32x2 __attribute__((ext_vector_type(2)));
typedef float f32x2_t __attribute__((ext_vector_type(2)));
typedef __bf16 bf16x2_t __attribute__((ext_vector_type(2)));
__device__ __forceinline__ unsigned cvtpk(float lo, float hi) { f32x2_t v = {lo, hi}; bf16x2_t b = __builtin_convertvector(v, bf16x2_t); return __builtin_bit_cast(unsigned, b); }
__device__ __forceinline__ float bflo(unsigned u) { return __uint_as_float(u << 16); }
__device__ __forceinline__ float bfhi(unsigned u) { return __uint_as_float(u & 0xffff0000u); }
__device__ __forceinline__ float partner(float x, int hi) { auto rr = __builtin_amdgcn_permlane32_swap(__float_as_uint(x), __float_as_uint(x), false, false); return __uint_as_float(hi ? rr[0] : rr[1]); }
__device__ __forceinline__ float wave_sum(float v) {
#pragma unroll
    for (int o = 1; o < 64; o <<= 1) v += __shfl_xor(v, o);
    return v;
}

#define XB_TMO      128
#define XB_XCNT(j)  (256  + 64 * (j))
#define XB_XSUB(j)  (1280 + 64 * (j))
#define XB_XGEN(j)  (2304 + 64 * (j))
#define XB_TOP      3328
#define XB_TOPGEN   3392
#define XCD_BAR_WORDS 3456
#define XB_SPIN_CAP (1u << 18)

__device__ __forceinline__ unsigned xb_ld(unsigned* p)              { return __hip_atomic_load(p, __ATOMIC_RELAXED, __HIP_MEMORY_SCOPE_AGENT); }
__device__ __forceinline__ unsigned xb_add(unsigned* p, unsigned v) { return __hip_atomic_fetch_add(p, v, __ATOMIC_RELAXED, __HIP_MEMORY_SCOPE_AGENT); }
__device__ __forceinline__ unsigned xb_xcc_id() { return (unsigned)__builtin_amdgcn_s_getreg((3 << 11) | 20) & 0xFu; }
#define XB_SPIN(cond, bar) do { unsigned _sp = 0; while (cond) { __builtin_amdgcn_s_sleep(1); \
    if ((++_sp & 255u) == 0u) { if (xb_ld(&(bar)[XB_TMO])) break; if (_sp > XB_SPIN_CAP) { atomicAdd(&(bar)[XB_TMO], 1u); break; } } } } while (0)

struct XcdBarrier {
    unsigned* bar; unsigned x;
    volatile LAS unsigned* st;
};

__device__ __forceinline__ XcdBarrier xcd_barrier_post(unsigned* bar, volatile LAS unsigned* st) {
    XcdBarrier b; b.bar = bar; b.x = xb_xcc_id(); b.st = st;
    if (threadIdx.x == 0) (void)xb_add(&bar[XB_XCNT(b.x)], 1u);
    return b;
}
__device__ __forceinline__ void xcd_barrier_complete(unsigned* bar, unsigned x, unsigned& nloc, unsigned& nx) {
    const unsigned G = gridDim.x * gridDim.y * gridDim.z;
    unsigned sum, cnt, mine, sp = 0u;
    for (;;) {
        sum = 0u; cnt = 0u; mine = 0u;
#pragma unroll
        for (unsigned j = 0; j < 16; ++j) { const unsigned c = xb_ld(&bar[XB_XCNT(j)]); sum += c; cnt += (c > 0u) ? 1u : 0u; mine = (j == x) ? c : mine; }
        if (sum == G) break;
        __builtin_amdgcn_s_sleep(1);
        if ((++sp & 255u) == 0u) { if (xb_ld(&bar[XB_TMO])) break; if (sp > XB_SPIN_CAP) { atomicAdd(&bar[XB_TMO], 1u); break; } }
    }
    nloc = mine > 0u ? mine : 1u; nx = cnt > 0u ? cnt : 1u;
}

__device__ __forceinline__ void xcd_barrier(const XcdBarrier& b) {
    int t0_ = threadIdx.x; asm volatile("" : "+v"(t0_));
    asm volatile("s_waitcnt vmcnt(0)" ::: "memory");
    __syncthreads();
    if (t0_ == 0) {
        unsigned* bar = b.bar;
        __builtin_amdgcn_s_waitcnt(0);
        unsigned nloc = b.st[0], nx = b.st[1];
        if (nloc == 0u) { xcd_barrier_complete(bar, b.x, nloc, nx); b.st[0] = nloc; b.st[1] = nx; }
        const unsigned old = xb_add(&bar[XB_XSUB(b.x)], 1u);
        const unsigned gen = old / nloc;
        if (old + 1u == (gen + 1u) * nloc) {
            __builtin_amdgcn_fence(__ATOMIC_RELEASE, "agent");
            asm volatile("s_waitcnt vmcnt(0)" ::: "memory");
            const unsigned og = xb_add(&bar[XB_TOP], 1u);
            const unsigned tg = og / nx;
            if (og + 1u == (tg + 1u) * nx) xb_add(&bar[XB_TOPGEN], 1u);
            else XB_SPIN(xb_ld(&bar[XB_TOPGEN]) == tg, bar);
            __builtin_amdgcn_fence(__ATOMIC_ACQUIRE, "agent");
            xb_add(&bar[XB_XGEN(b.x)], 1u);
            asm volatile("s_waitcnt vmcnt(0)" ::: "memory");
        } else {
            XB_SPIN(xb_ld(&bar[XB_XGEN(b.x)]) == gen, bar);
            __builtin_amdgcn_fence(__ATOMIC_ACQUIRE, "agent");
            asm volatile("s_waitcnt vmcnt(0)" ::: "memory");
        }
    }
    __syncthreads();
}

__device__ __forceinline__ void grid_barrier(const XcdBarrier& b) {
    XcdBarrier c = b; unsigned long long p = (unsigned long long)c.bar; unsigned x = c.x;
    asm volatile("" : "+s"(p), "+s"(x));
    c.bar = (unsigned*)p; c.x = x;
    xcd_barrier(c);
}

__device__ __forceinline__ void transpose_item(const float* __restrict__ W, const float* __restrict__ gain, int K, int N, bf16* __restrict__ WT, LAS float* scr, int item, int lane) {
    const int nblk = N / 32, jb = item >> 3, nbh = jb % (nblk / 4), kbh = jb / (nblk / 4), nb = 4 * nbh + (item & 3), kb = 2 * kbh + ((item >> 2) & 1), k0 = 64 * kb, n0 = 32 * nb;
#pragma unroll 8
    for (int i = 0; i < 32; ++i) { const int kk = 2 * i + (lane >> 5); scr[kk * 33 + (lane & 31)] = __builtin_nontemporal_load(W + (size_t)(k0 + kk) * N + n0 + (lane & 31)); }
    asm volatile("s_waitcnt lgkmcnt(0)" ::: "memory");
    const int c = lane & 7;
    f32x4 ga = {1.f, 1.f, 1.f, 1.f}, gb = {1.f, 1.f, 1.f, 1.f};
    if (gain) { ga = *(const f32x4*)(gain + k0 + 8 * c); gb = *(const f32x4*)(gain + k0 + 8 * c + 4); }
#pragma unroll
    for (int j = 0; j < 4; ++j) { const int n = (lane >> 3) + 8 * j; const LAS float* s = scr + (8 * c) * 33 + n;
        u32x4 o; o.x = cvtpk(s[0 * 33] * ga.x, s[1 * 33] * ga.y); o.y = cvtpk(s[2 * 33] * ga.z, s[3 * 33] * ga.w); o.z = cvtpk(s[4 * 33] * gb.x, s[5 * 33] * gb.y); o.w = cvtpk(s[6 * 33] * gb.z, s[7 * 33] * gb.w);
        *(u32x4*)(WT + (size_t)(n0 + n) * K + k0 + 8 * c) = o; }
    asm volatile("s_waitcnt lgkmcnt(0)" ::: "memory");
}
__device__ __forceinline__ void cast_rows(const float* __restrict__ x, bf16* __restrict__ out, float* __restrict__ ssq, int gw, int ngw, int lane) {
    for (int m = gw; m < MTOK; m += ngw) {
        const f32x4* xr = (const f32x4*)(x + (size_t)m * DM) + lane;
        u32x2* o = (u32x2*)(out + (size_t)m * DM) + lane;
        float s = 0.f;
#pragma unroll
        for (int j = 0; j < 8; ++j) { const f32x4 v = __builtin_nontemporal_load(xr + 64 * j); s += (v.x * v.x + v.y * v.y) + (v.z * v.z + v.w * v.w); u32x2 w; w.x = cvtpk(v.x, v.y); w.y = cvtpk(v.z, v.w); o[64 * j] = w; }
        s = wave_sum(s);
        if (lane < 32) ssq[(size_t)m * 32 + lane] = lane == 0 ? s : 0.f;
    }
}

namespace att {
constexpr int TILEB = 16384, BUFB = 2 * TILEB, NBUF = 3;
constexpr int OFF_RK = NBUF * BUFB, OFF_TAB = OFF_RK + 3072, OFF_GQK = OFF_TAB + 1536, OFF_FLAG = OFF_GQK + 512, OFF_QIDX = OFF_FLAG + 64, LDS_NEED = OFF_QIDX + 16;
constexpr int NPT = 383;
static_assert(LDS_NEED <= 131072, "attention LDS");
__device__ __forceinline__ int swz(int row) { return ((row & 3) << 2) | ((row >> 2) & 3); }

template <int MODE>
__device__ __forceinline__ void unit(LAS unsigned char* lds, const bf16* __restrict__ proj, bf16* __restrict__ mix, int b, int h, int blk,
                                     const float* __restrict__ qg, const float* __restrict__ kg, const float* __restrict__ rel, const float* __restrict__ kn, unsigned* cnt) {
    int tid_ = threadIdx.x; asm volatile("" : "+v"(tid_));
    const int tid = tid_, lane = tid & 63, wid = __builtin_amdgcn_readfirstlane(tid >> 6), r32 = lane & 31, hi = lane >> 5;
    constexpr int G0 = MODE ? 4 : 0;
    const bf16* pq = proj + (size_t)((G0 + 0) * 8 + h) * MTOK * HD; const bf16* pk = proj + (size_t)((G0 + 1) * 8 + h) * MTOK * HD;
    const bf16* pv = proj + (size_t)((G0 + 2) * 8 + h) * MTOK * HD; const bf16* pg = proj + (size_t)((G0 + 3) * 8 + h) * MTOK * HD; const int mcol = MODE * 1024 + h * HD;
    const int q0 = blk * 256, tw = q0 + 32 * wid;
    const size_t rowb = (size_t)b * SEQ;
    LAS float* RK = (LAS float*)(lds + OFF_RK); LAS float* TAB = (LAS float*)(lds + OFF_TAB); LAS float* GQK = (LAS float*)(lds + OFF_GQK);
    int kt_first, kt_step, ntile;
    if (MODE == 0) { kt_first = blk * 4 + 3; kt_step = -1; ntile = blk * 4 + 4; }
    else { const int lo = blk * 4 - 8 < 0 ? 0 : blk * 4 - 8; kt_first = lo; kt_step = 1; ntile = blk * 4 + 3 - lo + 1; }
    unsigned gofs[2];
#pragma unroll
    for (int j = 0; j < 2; ++j) { const int r = 4 * (2 * wid + j) + (lane >> 4); gofs[j] = (unsigned)(r * HD + (((lane & 15) ^ swz(r)) << 3)); }
    const bf16* kbase = pk + rowb * HD; const bf16* vbase = pv + rowb * HD;
#define ATT_DMA(kt, bi) do { const size_t to_ = (size_t)(64 * (kt)) * HD; LAS unsigned char* d_ = lds + (bi) * BUFB + wid * 2048; _Pragma("unroll") for (int j_ = 0; j_ < 2; ++j_) { \
        __builtin_amdgcn_global_load_lds((const unsigned*)(kbase + to_ + gofs[j_]), (LAS unsigned*)(d_ + j_ * 1024), 16, 0, 0); \
        __builtin_amdgcn_global_load_lds((const unsigned*)(vbase + to_ + gofs[j_]), (LAS unsigned*)(d_ + TILEB + j_ * 1024), 16, 0, 0); } } while (0)
    ATT_DMA(kt_first, 0);
    if (ntile > 1) ATT_DMA(kt_first + kt_step, 1);
    bf16x8 qf[8];
    { const bf16* qrow = pq + (rowb + tw + r32) * HD + 8 * hi;
#pragma unroll
      for (int d0 = 0; d0 < 8; ++d0) qf[d0] = *(const bf16x8*)(qrow + 16 * d0); }
    float rq = 1.0f;
    if (MODE == 1) {
        if (tid < NPT) TAB[tid] = rel[h * NREL + (NREL - 1) - (tid > 63 ? tid - 63 : 0)] * LOG2E;
        if (tid < HD) GQK[tid] = qg[tid] * kg[tid] * (QSCALE * LOG2E);
        const f32x4 qp = *(const f32x4*)(kn + ((size_t)h * MTOK + rowb + tw + r32) * 4);
        rq = 1.0f / sqrtf(((qp.x + qp.y) + (qp.z + qp.w)) * (1.0f / HD) + EPS);
        const int nkeys = 64 * ntile; const float* knk = kn + ((size_t)(8 + h) * MTOK + rowb + 64 * kt_first) * 4;
#pragma unroll
        for (int i = 0; i < 2; ++i) { const int key = tid + 512 * i; if (key < nkeys) { const f32x4 kp = *(const f32x4*)(knk + (size_t)key * 4); RK[key] = 1.0f / sqrtf(((kp.x + kp.y) + (kp.z + kp.w)) * (1.0f / HD) + EPS); } }
    }
    asm volatile("s_waitcnt vmcnt(0) lgkmcnt(0)" ::: "memory");
    __builtin_amdgcn_s_barrier();
    asm volatile("" ::: "memory");
    if (MODE == 1) {
#pragma unroll
        for (int d0 = 0; d0 < 8; ++d0) { const u32x4 u = __builtin_bit_cast(u32x4, qf[d0]); const f32x4 g0 = *(const LAS f32x4*)(GQK + 16 * d0 + 8 * hi), g1 = *(const LAS f32x4*)(GQK + 16 * d0 + 8 * hi + 4);
            u32x4 o; o.x = cvtpk(bflo(u.x) * rq * g0.x, bfhi(u.x) * rq * g0.y); o.y = cvtpk(bflo(u.y) * rq * g0.z, bfhi(u.y) * rq * g0.w);
            o.z = cvtpk(bflo(u.z) * rq * g1.x, bfhi(u.z) * rq * g1.y); o.w = cvtpk(bflo(u.w) * rq * g1.z, bfhi(u.w) * rq * g1.w);
            qf[d0] = __builtin_bit_cast(bf16x8, o); }
    }
    f32x16 O[4];
#pragma unroll
    for (int i = 0; i < 4; ++i) O[i] = f32x16{};
    float carry = 1.0f, mrun = -1e30f, lrun = 0.f;
    bool wdone = false;
    LAS unsigned* FLG = (LAS unsigned*)(lds + OFF_FLAG);
    const int g4 = (r32 >> 2) & 3;
    const int pi = (r32 & 16) + (g4 == 1 ? 8 : g4 == 2 ? 4 : g4 * 4) + (r32 & 3);
    int kx[8], vx[4][2];
#pragma unroll
    for (int e = 0; e < 8; ++e) kx[e] = 256 * pi + 16 * ((2 * e + hi) ^ swz(pi));
    { const int q = (lane & 15) >> 2, p = lane & 3, bk = (lane >> 4) & 1;
#pragma unroll
      for (int db = 0; db < 4; ++db)
#pragma unroll
          for (int t = 0; t < 2; ++t) vx[db][t] = TILEB + 256 * (8 * hi + 4 * t + q) + 16 * (((db ^ q) << 2) | ((2 * bk + (p >> 1)) ^ (2 * hi + t))) + 8 * (p & 1); }
    const int cw = blk * 4 + (wid >> 1);
    int cur = 0;
    for (int it = 0; it < ntile; ++it) {
        const int kt = kt_first + kt_step * it;
        const int nx1 = cur == 2 ? 0 : cur + 1, nx2 = nx1 == 2 ? 0 : nx1 + 1;
        if (it + 2 < ntile) ATT_DMA(kt + 2 * kt_step, nx2);
        const LAS unsigned char* Kb = lds + cur * BUFB;
#define ATT_SBAR() __builtin_amdgcn_sched_barrier(0)
#define ATT_KLOAD(KF, b2) do { const LAS unsigned char* Kh_ = Kb + (b2) * 8192; _Pragma("unroll") for (int d0 = 0; d0 < 8; ++d0) KF[d0] = *(const LAS bf16x8*)(Kh_ + kx[d0]); } while (0)
#define ATT_QK2(PA, KA, PB, KB) do { PA = f32x16{}; PB = f32x16{}; _Pragma("unroll") for (int d0 = 0; d0 < 8; ++d0) { \
            PA = __builtin_amdgcn_mfma_f32_32x32x16_bf16(KA[d0], qf[d0], PA, 0, 0, 0); PB = __builtin_amdgcn_mfma_f32_32x32x16_bf16(KB[d0], qf[d0], PB, 0, 0, 0); } } while (0)
#define ATT_VLOAD(VF, b2) do { const LAS unsigned char* Kh_ = Kb + (b2) * 8192; _Pragma("unroll") for (int j = 0; j < 2; ++j) _Pragma("unroll") for (int db = 0; db < 4; ++db) { \
                const v4i16_t lo_ = __builtin_amdgcn_ds_read_tr16_b64_v4i16((LAS v4i16_t*)(Kh_ + j * 4096 + vx[db][0])); \
                const v4i16_t hi_ = __builtin_amdgcn_ds_read_tr16_b64_v4i16((LAS v4i16_t*)(Kh_ + j * 4096 + vx[db][1])); \
                VF[j][db] = (bf16x8){lo_[0], lo_[1], lo_[2], lo_[3], hi_[0], hi_[1], hi_[2], hi_[3]}; } } while (0)
#define ATT_PVM(P, VF) do { bf16x8 pf_[2]; { u32x4 w_; \
              w_.x = cvtpk(P[0], P[1]); w_.y = cvtpk(P[2], P[3]); w_.z = cvtpk(P[4], P[5]); w_.w = cvtpk(P[6], P[7]); pf_[0] = __builtin_bit_cast(bf16x8, w_); \
              w_.x = cvtpk(P[8], P[9]); w_.y = cvtpk(P[10], P[11]); w_.z = cvtpk(P[12], P[13]); w_.w = cvtpk(P[14], P[15]); pf_[1] = __builtin_bit_cast(bf16x8, w_); } \
            _Pragma("unroll") for (int j = 0; j < 2; ++j) _Pragma("unroll") for (int db = 0; db < 4; ++db) O[db] = __builtin_amdgcn_mfma_f32_32x32x16_bf16(VF[j][db], pf_[j], O[db], 0, 0, 0); } while (0)
#define ATT_SB(P, b2) do { const int k0_ = 64 * kt + 32 * (b2), trel_ = (tw + r32) - k0_; float st[16]; \
            _Pragma("unroll") for (int r = 0; r < 16; ++r) { const float e_ = __builtin_amdgcn_exp2f(fminf(P[r] * (QSCALE * LOG2E), 60.0f)); st[r] = __builtin_amdgcn_rcpf(1.0f + e_); P[r] = e_; } \
            if (k0_ + 31 >= tw) {   \
                _Pragma("unroll") for (int r = 0; r < 16; ++r) { const int ko_ = 16 * (r >> 3) + 8 * hi + (r & 7); if (!(ko_ < trel_)) { st[r] = 1.0f; P[r] = 0.f; } } } \
            _Pragma("unroll") for (int r = 6; r >= 0; --r) { st[r] *= st[r + 1]; st[r + 8] *= st[r + 9]; } \
            const float A_ = st[0], B_ = st[8]; const float Ap_ = partner(A_, hi), Bp_ = partner(B_, hi); \
            const float cA_ = carry * (hi ? (Bp_ * B_) : (Ap_ * B_ * Bp_)), cB_ = carry * (hi ? 1.0f : Bp_); \
            _Pragma("unroll") for (int r = 0; r < 8; ++r) { P[r] = (P[r] * st[r]) * cA_; P[r + 8] = (P[r + 8] * st[r + 8]) * cB_; } \
            carry *= (A_ * B_) * (Ap_ * Bp_); } while (0)
#define ATT_CB(P, b2) do { const int trel_ = (tw + r32) - (64 * kt + 32 * (b2)); const LAS float* RKb_ = RK + it * 64 + 32 * (b2) + 8 * hi; float mx_; \
            { const f32x4 r0_ = *(const LAS f32x4*)(RKb_), r1_ = *(const LAS f32x4*)(RKb_ + 4), r2_ = *(const LAS f32x4*)(RKb_ + 16), r3_ = *(const LAS f32x4*)(RKb_ + 20); float bs_[16]; \
              if ((cw - kt) >= 5) { const float bc_ = TAB[0]; _Pragma("unroll") for (int r = 0; r < 16; ++r) bs_[r] = bc_; } \
              else { const LAS float* PTl_ = TAB + (256 + 63 - trel_ + 8 * hi); _Pragma("unroll") for (int r = 0; r < 16; ++r) bs_[r] = PTl_[16 * (r >> 3) + (r & 7)]; } \
              _Pragma("unroll") for (int e = 0; e < 4; ++e) { P[e] = __builtin_fmaf(P[e], r0_[e], bs_[e]); P[4 + e] = __builtin_fmaf(P[4 + e], r1_[e], bs_[4 + e]); P[8 + e] = __builtin_fmaf(P[8 + e], r2_[e], bs_[8 + e]); P[12 + e] = __builtin_fmaf(P[12 + e], r3_[e], bs_[12 + e]); } \
              float m0_ = fmaxf(fmaxf(P[0], P[1]), P[2]), m1_ = fmaxf(fmaxf(P[3], P[4]), P[5]); \
              m0_ = fmaxf(fmaxf(m0_, P[6]), P[7]); m1_ = fmaxf(fmaxf(m1_, P[8]), P[9]); m0_ = fmaxf(fmaxf(m0_, P[10]), P[11]); m1_ = fmaxf(fmaxf(m1_, P[12]), P[13]); \
              mx_ = fmaxf(fmaxf(m0_, m1_), fmaxf(P[14], P[15])); } \
            mx_ = fmaxf(mx_, partner(mx_, hi)); \
            if (__any(mx_ > mrun + 8.0f)) { const float mn_ = fmaxf(mrun, mx_), al_ = __builtin_amdgcn_exp2f(mrun - mn_); lrun *= al_; mrun = mn_; \
                _Pragma("unroll") for (int i = 0; i < 4; ++i) _Pragma("unroll") for (int r = 0; r < 16; ++r) O[i][r] *= al_; } \
            float ls_ = 0.f; _Pragma("unroll") for (int r = 0; r < 16; ++r) { P[r] = __builtin_amdgcn_exp2f(P[r] - mrun); ls_ += P[r]; } \
            lrun += ls_; } while (0)
        const bool relevant = (MODE == 0) ? (64 * kt <= tw + 30 && !wdone) : (kt >= cw - 8 && kt <= cw);
        if (relevant) {
            constexpr int bA = (MODE == 0) ? 1 : 0, bB = 1 - bA;
            f32x16 pA = f32x16{}, pB = f32x16{}; bf16x8 kA[8], kB[8], vA[2][4], vB[2][4];
            ATT_KLOAD(kA, bA); ATT_SBAR();
            __builtin_amdgcn_s_setprio(1);
            { const LAS unsigned char* Kh_ = Kb + bB * 8192;
#pragma unroll
              for (int d0 = 0; d0 < 8; ++d0) { pA = __builtin_amdgcn_mfma_f32_32x32x16_bf16(kA[d0], qf[d0], pA, 0, 0, 0); kB[d0] = *(const LAS bf16x8*)(Kh_ + kx[d0]); } }
            ATT_SBAR();
            ATT_VLOAD(vA, bA);
#pragma unroll
            for (int d0 = 0; d0 < 8; ++d0) pB = __builtin_amdgcn_mfma_f32_32x32x16_bf16(kB[d0], qf[d0], pB, 0, 0, 0);
            __builtin_amdgcn_s_setprio(0);
            ATT_SBAR();
            if (MODE == 0) ATT_SB(pA, bA); else ATT_CB(pA, bA);
            ATT_SBAR();
            __builtin_amdgcn_s_setprio(1); ATT_PVM(pA, vA); __builtin_amdgcn_s_setprio(0); ATT_VLOAD(vB, bB); ATT_SBAR();
            if (MODE == 0) ATT_SB(pB, bB); else ATT_CB(pB, bB);
            ATT_SBAR();
            __builtin_amdgcn_s_setprio(1); ATT_PVM(pB, vB); __builtin_amdgcn_s_setprio(0);
        }
#undef ATT_SBAR
#undef ATT_KLOAD
#undef ATT_QK2
#undef ATT_VLOAD
#undef ATT_PVM
#undef ATT_SB
#undef ATT_CB
        if (MODE == 0) { wdone = !__any(carry >= 0x1p-100f); if (lane == 0) FLG[(it & 1) * 8 + wid] = wdone ? 1u : 0u; }
        if (it + 2 < ntile) asm volatile("s_waitcnt vmcnt(4) lgkmcnt(0)" ::: "memory"); else asm volatile("s_waitcnt vmcnt(0) lgkmcnt(0)" ::: "memory");
        __builtin_amdgcn_s_barrier();
        asm volatile("" ::: "memory");
        if (MODE == 0) { const u32x4 fa = *(const LAS u32x4*)(FLG + (it & 1) * 8), fb = *(const LAS u32x4*)(FLG + (it & 1) * 8 + 4);
            if ((fa.x & fa.y & fa.z & fa.w & fb.x & fb.y & fb.z & fb.w) != 0u) break; }
        cur = nx1;
    }
#undef ATT_DMA
    asm volatile("s_waitcnt vmcnt(0) lgkmcnt(0)" ::: "memory");
    __builtin_amdgcn_s_barrier();
    asm volatile("" ::: "memory");
    float inv = 1.0f;
    if (MODE == 1) { lrun += partner(lrun, hi); inv = 1.0f / lrun; }
    LAS unsigned char* stg = lds + wid * (32 * 272);
    { const bf16* gbase = pg + (rowb + tw) * HD; u32x4 gr[8];
#pragma unroll
      for (int i = 0; i < 8; ++i) gr[i] = *(const u32x4*)(gbase + (size_t)(4 * i + (lane >> 4)) * HD + (lane & 15) * 8);
#pragma unroll
      for (int i = 0; i < 8; ++i) *(LAS u32x4*)(stg + (4 * i + (lane >> 4)) * 272 + (lane & 15) * 16) = gr[i]; }
    asm volatile("s_waitcnt lgkmcnt(0)" ::: "memory");
    u32x2 gv[4][4];
#pragma unroll
    for (int db = 0; db < 4; ++db)
#pragma unroll
        for (int rg = 0; rg < 4; ++rg) gv[db][rg] = *(const LAS u32x2*)(stg + r32 * 272 + (32 * db + 8 * rg + 4 * hi) * 2);
    asm volatile("s_waitcnt lgkmcnt(0)" ::: "memory");
#pragma unroll
    for (int db = 0; db < 4; ++db)
#pragma unroll
        for (int rg = 0; rg < 4; ++rg) {
            const u32x2 g = gv[db][rg];
            u32x2 o; o.x = cvtpk(O[db][4 * rg + 0] * inv * bflo(g.x), O[db][4 * rg + 1] * inv * bfhi(g.x));
            o.y = cvtpk(O[db][4 * rg + 2] * inv * bflo(g.y), O[db][4 * rg + 3] * inv * bfhi(g.y));
            *(LAS u32x2*)(stg + r32 * 272 + (32 * db + 8 * rg + 4 * hi) * 2) = o;
        }
    asm volatile("s_waitcnt lgkmcnt(0)" ::: "memory");
    bf16* obase = mix + (rowb + tw) * DM + mcol;
#pragma unroll
    for (int i = 0; i < 8; ++i) { const int row = 4 * i + (lane >> 4), ch = lane & 15;
        const u32x4 v = *(const LAS u32x4*)(stg + row * 272 + ch * 16);
        asm volatile("global_store_dwordx4 %0, %1, off sc1\n\ts_nop 1" :: "v"(obase + (size_t)row * DM + ch * 8), "v"(v) : "memory"); }
    asm volatile("s_waitcnt vmcnt(0)" ::: "memory");
    __syncthreads();
    if (tid == 0) __hip_atomic_fetch_add(cnt, 1u, __ATOMIC_RELAXED, __HIP_MEMORY_SCOPE_AGENT);
}

__device__ __forceinline__ void decode(int x, int e, int& mode, int& bh, int& blk) {
    bh = 4 * x + (e & 3); const int g = e >> 2;
    if (g < 6) { mode = 1; blk = 7 - g; return; }
    if (g == 6) { mode = 1; blk = 1; return; }
    if (g < 14) { mode = 0; blk = 14 - g; return; }
    if (g == 14) { mode = 1; blk = 0; return; }
    mode = 0; blk = 0;
}
__device__ __forceinline__ void phase(LAS unsigned char* lds, unsigned* heads, unsigned* cnts, int myx, const bf16* proj, bf16* mix, const float* qg, const float* kg, const float* rel, const float* kn) {
    LAS int* slot = (LAS int*)(lds + OFF_QIDX);
    int t1_ = threadIdx.x; asm volatile("" : "+v"(t1_));
    const int lane = t1_ & 63, wid = __builtin_amdgcn_readfirstlane(t1_ >> 6);
    int x = myx & 7, par = 0;
    for (;;) {
        if (wid == 0) {
            int e = -1;
            for (;;) {
                unsigned v = 64u; if (lane == 0) v = __hip_atomic_fetch_add(heads + 64 * x, 1u, __ATOMIC_RELAXED, __HIP_MEMORY_SCOPE_AGENT);
                v = (unsigned)__builtin_amdgcn_readfirstlane((int)v);
                if (v < 64u) { e = (int)v; break; }
                unsigned h = 64u; if (lane < 8) h = __hip_atomic_load(heads + 64 * lane, __ATOMIC_RELAXED, __HIP_MEMORY_SCOPE_AGENT);
                const unsigned long long m = __ballot(h < 64u);
                if (m == 0ull) break;
                const unsigned m8 = (unsigned)m & 0xffu, rot = ((m8 >> x) | (m8 << (8 - x))) & 0xffu;
                x = (x + __builtin_ctz(rot)) & 7;
            }
            if (lane == 0) { slot[2 * par] = e; slot[2 * par + 1] = x; }
        }
        __syncthreads();
        const int e = __builtin_amdgcn_readfirstlane(slot[2 * par]), xq = __builtin_amdgcn_readfirstlane(slot[2 * par + 1]);
        par ^= 1;
        if (e < 0) break;
        int mode, bh, blk; decode(xq, e, mode, bh, blk);
        unsigned* cnt = cnts + ((bh >> 3) * 8 + blk) * 16;
        if (mode == 0) unit<0>(lds, proj, mix, bh >> 3, bh & 7, blk, qg, kg, rel, kn, cnt);
        else unit<1>(lds, proj, mix, bh >> 3, bh & 7, blk, qg, kg, rel, kn, cnt);
    }
}
}

__device__ __forceinline__ int draw32(unsigned* base, int stride, int& x, int lane) {
    for (;;) {
        unsigned v = 32u; if (lane == 0) v = __hip_atomic_fetch_add(base + stride * x, 1u, __ATOMIC_RELAXED, __HIP_MEMORY_SCOPE_AGENT);
        v = (unsigned)__builtin_amdgcn_readfirstlane((int)v);
        if (v < 32u) return (int)v;
        unsigned hh = 32u; if (lane < 8) hh = __hip_atomic_load(base + stride * lane, __ATOMIC_RELAXED, __HIP_MEMORY_SCOPE_AGENT);
        const unsigned long long m = __ballot(hh < 32u);
        if (m == 0ull) return -1;
        const unsigned m8 = (unsigned)m & 0xffu, rot = ((m8 >> x) | (m8 << (8 - x))) & 0xffu;
        x = (x + __builtin_ctz(rot)) & 7;
    }
}

struct Args { const float* x; const float* norm_g; const float* w_in; const float* qg; const float* kg; const float* rel; const float* w_out; float* out; unsigned char* ws; int cg_sync; int pad; };

__global__ void __launch_bounds__(512, 2) fwd_megakernel(Args a) {
    extern __shared__ __attribute__((aligned(16))) unsigned char lds_raw[];
    cg::grid_group grid = cg::this_grid();
    LAS unsigned char* lds = (LAS unsigned char*)lds_raw;
    const int tid = threadIdx.x, lane = tid & 63, wave = __builtin_amdgcn_readfirstlane(tid >> 6);
    const int G = gridDim.x, gw = blockIdx.x * 8 + wave, ngw = G * 8;
    unsigned* ctl = (unsigned*)(a.ws + WS_CTL);
    if (tid < 2) ((LAS unsigned*)(lds + MISC_OFF))[tid] = 0u;
    __syncthreads();
    const XcdBarrier bar = xcd_barrier_post(ctl + CW_BAR, (volatile LAS unsigned*)(lds + MISC_OFF));
    bf16* WIN = (bf16*)(a.ws + WS_WIN); bf16* WOUT = (bf16*)(a.ws + WS_WOUT); bf16* XN = (bf16*)(a.ws + WS_XN); float* SSQ = (float*)(a.ws + WS_SSQ); float* KN0 = (float*)(a.ws + WS_KN); bf16* PROJ0 = (bf16*)(a.ws + WS_PROJ); bf16* MIX = (bf16*)(a.ws + WS_MIX);

    {
        LAS float* scr = (LAS float*)(lds + wave * 16384);
        constexpr int I_IN = (DM / 64) * (DIN / 32), I_OUT = (DM / 64) * (DM / 32), I_L = I_IN + I_OUT;
        for (int it = gw; it < DEPTH * I_L; it += ngw) {
            const int l = DEPTH - 1 - it / I_L, r = it % I_L;
            if (r < I_IN) transpose_item(a.w_in + (size_t)l * DM * DIN, a.norm_g + (size_t)l * DM, DM, DIN, WIN + (size_t)l * DIN * DM, scr, r, lane);
            else transpose_item(a.w_out + (size_t)l * DM * DM, nullptr, DM, DM, WOUT + (size_t)l * DM * DM, scr, r - I_IN, lane);
        }
        cast_rows(a.x, XN, SSQ, gw, ngw, lane);
    }
    if (a.cg_sync) grid.sync();
    grid_barrier(bar);
    for (int l = 0; l < DEPTH; ++l) {
        bf16* PROJ = (l & 1) ? (bf16*)(a.ws + WS_PROJ1) : PROJ0; float* KN = (l & 1) ? (float*)(a.ws + WS_KN1) : KN0;
        int Gl = G, bx = (int)blockIdx.x; asm volatile("" : "+s"(Gl), "+s"(bx));
        { pg8::Gemm g{XN, WIN + (size_t)l * DIN * DM, MTOK, DIN, DM};
          LAS float* RSL = (LAS float*)(lds + RS_OFF);
          int t3 = threadIdx.x; asm volatile("" : "+v"(t3));
          int so1 = RS_OFF; asm volatile("" : "+s"(so1)); LAS int* slot1 = (LAS int*)(lds + so1);
          int xs1 = (int)bar.x & 7; asm volatile("" : "+s"(xs1));
          if (t3 < 64) { int x = xs1; const int e = draw32(ctl + 512 * l + 16, 64, x, t3); if (t3 == 0) { slot1[0] = e; slot1[1] = x; } }
          __syncthreads();
          const int e1 = __builtin_amdgcn_readfirstlane(slot1[0]), x1 = __builtin_amdgcn_readfirstlane(slot1[1]);
          __syncthreads();
          if (e1 >= 0) {
          pg8::QuadOrder S{8 * (x1 >> 1) + 7 - (e1 >> 2), x1 & 1, e1 & 3};
          if (l > 0) {
              if (t3 < 64) { unsigned* cw = ctl + CW_CNT + ((l - 1) * 32 + S.pm) * 16; unsigned sp = 0;
                  while ((unsigned)__builtin_amdgcn_readfirstlane((int)__hip_atomic_load(cw, __ATOMIC_RELAXED, __HIP_MEMORY_SCOPE_AGENT)) < 8u) { __builtin_amdgcn_s_sleep(2); if (++sp > (1u << 22)) break; }
                  __builtin_amdgcn_fence(__ATOMIC_ACQUIRE, "agent");
                  asm volatile("s_waitcnt vmcnt(0)" ::: "memory"); }
              __syncthreads();
          }
          { pg8::Unit u; f32x4 pv[4][4]; int nu = 0;
            int t2 = threadIdx.x; asm volatile("" : "+v"(t2));
            const int row = t2 >> 1, hf = t2 & 1;
#pragma unroll
            for (int i = 0; i < 4; ++i) { if (S.next(i, u)) { nu = i + 1; const f32x4* pp = (const f32x4*)(SSQ + (size_t)(u.pm * 256 + row) * 32 + hf * 16);
#pragma unroll
                for (int j = 0; j < 4; ++j) pv[i][j] = pp[j]; } else {
#pragma unroll
                for (int j = 0; j < 4; ++j) pv[i][j] = (f32x4){0.f, 0.f, 0.f, 0.f}; } }
#pragma unroll
            for (int i = 0; i < 4; ++i) { const f32x4 s4 = (pv[i][0] + pv[i][1]) + (pv[i][2] + pv[i][3]); float s = (s4.x + s4.y) + (s4.z + s4.w); s += pg8::shfl_xor_l(s, t2 & 63, 1);
                if (hf == 0 && i < nu) RSL[i * 256 + row] = 1.0f / sqrtf(s * (1.0f / DM) + EPS); }
            __syncthreads(); }
          pg8::EpiProj E{PROJ, MTOK, RSL, KN};
          pg8::gemm_phase<pg8::EpiProj, pg8::QuadOrder, true, true>(lds, g, S, E); } }
        grid_barrier(bar);
        att::phase(lds, ctl + 512 * l, ctl + CW_CNTA + l * 512, (int)bar.x, PROJ, MIX, a.qg + l * HD, a.kg + l * HD, a.rel + (size_t)l * NH * NREL, KN);
        { pg8::Gemm g{MIX, WOUT + (size_t)l * DM * DM, MTOK, DM, DM};
          int t4 = threadIdx.x; asm volatile("" : "+v"(t4));
          int so3 = RS_OFF; asm volatile("" : "+s"(so3)); LAS int* slot3 = (LAS int*)(lds + so3);
          int xs3 = (int)bar.x & 7; asm volatile("" : "+s"(xs3));
          if (t4 < 64) { int x = xs3; const int e = draw32(ctl + 3584 + l * 128, 16, x, t4); if (t4 == 0) { slot3[0] = e; slot3[1] = x; } }
          __syncthreads();
          const int e3 = __builtin_amdgcn_readfirstlane(slot3[0]), x3 = __builtin_amdgcn_readfirstlane(slot3[1]);
          if (e3 >= 0) {
          const int pm3 = 8 * (x3 >> 1) + 7 - (e3 >> 2);
          pg8::OneUnit S{pm3, 4 * (x3 & 1) + (e3 & 3), (const unsigned*)(ctl + CW_CNTA + l * 512 + pm3 * 16), 16u};
          pg8::EpiRes E{a.out, XN, SSQ, DM, l == DEPTH - 1};
          pg8::gemm_phase<pg8::EpiRes, pg8::OneUnit, true, true>(lds, g, S, E);
          if (threadIdx.x == 0 && l + 1 < DEPTH) __hip_atomic_fetch_add(ctl + CW_CNT + (l * 32 + S.pm) * 16, 1u, __ATOMIC_RELAXED, __HIP_MEMORY_SCOPE_AGENT); } }
    }
}

extern "C" void kernel_launch(void* const* d_in, const int* in_sizes, int n_in, void* d_out, int out_size, void* d_ws, size_t ws_size, hipStream_t stream) {
    static int grid_blocks = 0;
    if (grid_blocks == 0) {
        if (n_in != 7 || out_size != MTOK * DM || ws_size < WS_END) { fprintf(stderr, "kernel_launch: unexpected shapes (n_in %d out %d ws %zu)\n", n_in, out_size, ws_size); grid_blocks = -1; return; }
        int dev = 0, cus = 0, per_cu = 0;
        (void)hipGetDevice(&dev);
        (void)hipDeviceGetAttribute(&cus, hipDeviceAttributeMultiprocessorCount, dev);
        (void)hipFuncSetAttribute((const void*)fwd_megakernel, hipFuncAttributeMaxDynamicSharedMemorySize, LDS_BYTES);
        (void)hipOccupancyMaxActiveBlocksPerMultiprocessor(&per_cu, (const void*)fwd_megakernel, 512, LDS_BYTES);
        if (per_cu < 1) { fprintf(stderr, "kernel_launch: occupancy query says %d blocks per CU\n", per_cu); per_cu = 1; }
        (void)hipGetLastError();
        if (cus * per_cu < 256) fprintf(stderr, "kernel_launch: the device reports %d CUs x %d resident blocks; this kernel's phase maps assume a 256-workgroup grid (MI355X)\n", cus, per_cu);
        grid_blocks = 256;
    }
    if (grid_blocks < 0) return;
    (void)hipMemsetAsync((char*)d_ws + WS_CTL, 0, CTL_ZERO_BYTES, stream);
    Args a{};
    a.x = (const float*)d_in[0]; a.norm_g = (const float*)d_in[1]; a.w_in = (const float*)d_in[2]; a.qg = (const float*)d_in[3]; a.kg = (const float*)d_in[4];
    a.rel = (const float*)d_in[5]; a.w_out = (const float*)d_in[6]; a.out = (float*)d_out; a.ws = (unsigned char*)d_ws;
    void* args[] = {&a};
    hipError_t e = hipLaunchCooperativeKernel((const void*)fwd_megakernel, dim3(grid_blocks), dim3(512), args, LDS_BYTES, stream);
    if (e != hipSuccess) fprintf(stderr, "cooperative launch failed: %s (grid %d)\n", hipGetErrorString(e), grid_blocks);
}
```
